# Optimizing an MI355X kernel written in HIP

```python
import math
import jax
import jax.numpy as jnp
from jax import lax
import numpy as np

D_MODEL = 1024
BATCH = 32
SEQ = 2048
DEPTH = 1

HEAD_DIM = 64
A_HEADS = 8
A_KV = 2
A_REP = A_HEADS // A_KV
A_WINDOW = 128
B_HEADS = 8
B_KV = 2
B_REP = B_HEADS // B_KV
CMP_LEN = 32
CMP_STRIDE = 16
CMP_HIDDEN = 128
SLC_LEN = 64
SLC_TOP = 8
SLC_LOCAL = 2
B_WINDOW = 512
N_BUCKETS = 32
REL_MAX_DIST = 128
N_EXPERTS = 32
TOP_K = 4
D_FF = D_MODEL
SWIGLU_LIMIT = 7.0
SWIGLU_ALPHA = 1.702
Q_BLOCK = 128
SLC_Q_BLOCK = 64
MOE_BLOCK = 256
LN_EPS = 1e-5
NEG_INF = -1e30
FORCED_SCORE = 1e30
DEEPNORM_ALPHA = (2 * DEPTH) ** 0.25
DEEPNORM_BETA = (8 * DEPTH) ** -0.25
A_WIDTH = A_HEADS * HEAD_DIM
B_WIDTH = B_HEADS * HEAD_DIM
A_KV_WIDTH = A_KV * HEAD_DIM
B_KV_WIDTH = B_KV * HEAD_DIM
IN_WIDTHS = (A_WIDTH, A_KV_WIDTH, A_KV_WIDTH, B_WIDTH, B_KV_WIDTH, B_KV_WIDTH, B_KV_WIDTH, B_KV_WIDTH, B_KV_WIDTH, B_KV_WIDTH, 3 * B_HEADS, 2 * D_MODEL)
IN_WIDTH = sum(IN_WIDTHS)

kernel_name = 'hybrid_swa_nsa_moe_block'


def layer_norm(x, g, b):
    xf = x.astype(jnp.float32)
    mu = jnp.mean(xf, axis=-1, keepdims=True)
    var = jnp.mean(jnp.square(xf - mu), axis=-1, keepdims=True)
    return ((xf - mu) * lax.rsqrt(var + LN_EPS)).astype(x.dtype) * g + b


def t5_bucket(rel):
    n = jnp.maximum(rel, 0)
    max_exact = N_BUCKETS // 2
    nf = jnp.maximum(n, 1).astype(jnp.float32)
    large = max_exact + (jnp.log(nf / max_exact) / math.log(REL_MAX_DIST / max_exact) * (N_BUCKETS - max_exact)).astype(jnp.int32)
    large = jnp.minimum(large, N_BUCKETS - 1)
    return jnp.where(n < max_exact, n, large)


def banded_attention(q, k, v, bias_table, window, sinks=None):
    bsz, seq, g, r, d = q.shape
    n_prev = -(-window // Q_BLOCK)
    kb = (n_prev + 1) * Q_BLOCK
    nb = seq // Q_BLOCK
    pad = ((0, 0), (n_prev * Q_BLOCK, 0), (0, 0), (0, 0))
    kp = jnp.pad(k, pad)
    vp = jnp.pad(v, pad)
    q_off = np.arange(Q_BLOCK)[:, None]
    k_off = np.arange(kb)[None, :]
    rel = n_prev * Q_BLOCK + q_off - k_off
    band = (rel >= 0) & (rel < window)
    bias = jnp.transpose(bias_table[t5_bucket(jnp.asarray(rel))], (2, 3, 0, 1))
    scale = d ** -0.5

    def one_block(i):
        qb = lax.dynamic_slice_in_dim(q, i * Q_BLOCK, Q_BLOCK, axis=1)
        kblk = lax.dynamic_slice_in_dim(kp, i * Q_BLOCK, kb, axis=1)
        vblk = lax.dynamic_slice_in_dim(vp, i * Q_BLOCK, kb, axis=1)
        s = jnp.einsum('bqgrd,bkgd->bgrqk', qb, kblk).astype(jnp.float32) * scale + bias
        kpos = i * Q_BLOCK - n_prev * Q_BLOCK + jnp.asarray(k_off)
        s = jnp.where(band & (kpos >= 0), s, NEG_INF)
        if sinks is None:
            p = jax.nn.softmax(s, axis=-1)
        else:
            sk = sinks.astype(jnp.float32)[None, :, :, None, None]
            m = jnp.maximum(jnp.max(s, axis=-1, keepdims=True), sk)
            e = jnp.exp(s - m)
            p = e / (jnp.sum(e, axis=-1, keepdims=True) + jnp.exp(sk - m))
        return jnp.einsum('bgrqk,bkgd->bqgrd', p.astype(v.dtype), vblk)

    out = lax.map(one_block, jnp.arange(nb))
    return jnp.moveaxis(out, 0, 1).reshape(bsz, seq, g, r, d)


def compress_blocks(kv, pos, w1, w2):
    bsz, seq, g, d = kv.shape
    nc = (seq - CMP_LEN) // CMP_STRIDE + 1
    idx = np.arange(nc)[:, None] * CMP_STRIDE + np.arange(CMP_LEN)[None, :]
    blocks = kv[:, idx] + pos[None, None, :, None, :]
    blocks = jnp.transpose(blocks, (0, 1, 3, 2, 4)).reshape(bsz, nc, g, CMP_LEN * d)
    return jax.nn.gelu(blocks @ w1) @ w2


def cmp_to_slc_matrix(nc, nslc):
    cs = np.arange(nc)[:, None] * CMP_STRIDE
    ss = np.arange(nslc)[None, :] * SLC_LEN
    ov = np.clip(np.minimum(cs + CMP_LEN, ss + SLC_LEN) - np.maximum(cs, ss), 0, None)
    return (ov / CMP_LEN).astype(np.float32)


def selected_attention(q, k, v, sel, bias_table):
    bsz, seq, g, r, d = q.shape
    nslc = seq // SLC_LEN
    top = sel.shape[-1]
    kt = jnp.transpose(k.reshape(bsz, nslc, SLC_LEN, g, d), (0, 3, 1, 2, 4))
    vt = jnp.transpose(v.reshape(bsz, nslc, SLC_LEN, g, d), (0, 3, 1, 2, 4))
    b_idx = jnp.arange(bsz)[:, None, None, None]
    g_idx = jnp.arange(g)[None, None, :, None]
    g_idx5 = jnp.arange(g)[None, None, :, None, None]
    scale = d ** -0.5

    def one_chunk(i):
        qc = lax.dynamic_slice_in_dim(q, i * SLC_Q_BLOCK, SLC_Q_BLOCK, axis=1)
        sc = lax.dynamic_slice_in_dim(sel, i * SLC_Q_BLOCK, SLC_Q_BLOCK, axis=1)
        kg = kt[b_idx, g_idx, sc]
        vg = vt[b_idx, g_idx, sc]
        kpos = sc[..., None] * SLC_LEN + jnp.arange(SLC_LEN)
        tpos = i * SLC_Q_BLOCK + jnp.arange(SLC_Q_BLOCK)
        rel = tpos[None, :, None, None, None] - kpos
        bias = jnp.moveaxis(bias_table[t5_bucket(rel), g_idx5], -1, 3)
        s = jnp.einsum('bqgrd,bqgnld->bqgrnl', qc, kg).astype(jnp.float32) * scale + bias
        s = jnp.where((rel >= 0)[:, :, :, None], s, NEG_INF)
        p = jax.nn.softmax(s.reshape(s.shape[:4] + (top * SLC_LEN,)), axis=-1).reshape(s.shape)
        return jnp.einsum('bqgrnl,bqgnld->bqgrd', p.astype(v.dtype), vg)

    out = lax.map(one_chunk, jnp.arange(seq // SLC_Q_BLOCK))
    return jnp.moveaxis(out, 0, 1).reshape(bsz, seq, g, r, d)


def nsa_attention(q, k_cmp, v_cmp, k_slc, v_slc, k_win, v_win, gate_logits, bias_table,
                  cmp_pos_k, cmp_w1_k, cmp_w2_k, cmp_pos_v, cmp_w1_v, cmp_w2_v):
    bsz, seq, g, r, d = q.shape
    scale = d ** -0.5
    t = np.arange(seq)
    kc = compress_blocks(k_cmp, cmp_pos_k, cmp_w1_k, cmp_w2_k)
    vc = compress_blocks(v_cmp, cmp_pos_v, cmp_w1_v, cmp_w2_v)
    nc = kc.shape[1]
    cmp_valid = (np.arange(nc) * CMP_STRIDE + CMP_LEN - 1)[None, :] <= t[:, None]
    s = jnp.einsum('bsgrd,bcgd->bgrsc', q, kc).astype(jnp.float32) * scale
    s = jnp.where(cmp_valid, s, NEG_INF)
    p_cmp = jnp.where(cmp_valid.any(axis=-1)[:, None], jax.nn.softmax(s, axis=-1), 0.0)
    o_cmp = jnp.einsum('bgrsc,bcgd->bsgrd', p_cmp.astype(vc.dtype), vc)
    nslc = seq // SLC_LEN
    imp = jnp.einsum('bgrsc,cj->bsgj', p_cmp, cmp_to_slc_matrix(nc, nslc))
    blk = np.arange(nslc)[None, :]
    cur = (t // SLC_LEN)[:, None]
    forced = (blk == 0) | ((blk <= cur) & (blk > cur - SLC_LOCAL))
    future = blk > cur
    imp = jnp.where(forced[:, None, :], FORCED_SCORE, imp)
    imp = jnp.where(future[:, None, :], NEG_INF, imp)
    _, sel = lax.top_k(imp, min(SLC_TOP, nslc))
    o_slc = selected_attention(q, k_slc, v_slc, sel, bias_table)
    o_win = banded_attention(q, k_win, v_win, bias_table, B_WINDOW)
    gts = jax.nn.sigmoid(gate_logits)
    return gts[..., 0:1] * o_cmp + gts[..., 1:2] * o_slc + gts[..., 2:3] * o_win


def hybrid_mixer(x, w_in, b_in, rel_bias, attn_sinks, cmp_pos_k, cmp_w1_k, cmp_w2_k,
                 cmp_pos_v, cmp_w1_v, cmp_w2_v, w_branch_a, w_branch_b, w_out):
    bsz, seq, _ = x.shape
    proj = x @ w_in + b_in
    splits = []
    off = 0
    for w in IN_WIDTHS[:-1]:
        off += w
        splits.append(off)
    (qa, ka, va, qb, kbc, vbc, kbs, vbs, kbw, vbw, nsa_g, merge_g) = jnp.split(proj, splits, axis=-1)

    def heads(z, g, r):
        return z.reshape(bsz, seq, g, r, HEAD_DIM)

    def kvh(z, g):
        return z.reshape(bsz, seq, g, HEAD_DIM)

    bias_a = rel_bias[:, :A_HEADS].reshape(N_BUCKETS, A_KV, A_REP)
    bias_b = rel_bias[:, A_HEADS:].reshape(N_BUCKETS, B_KV, B_REP)
    y_a = banded_attention(heads(qa, A_KV, A_REP), kvh(ka, A_KV), kvh(va, A_KV), bias_a,
                           A_WINDOW, attn_sinks.reshape(A_KV, A_REP))
    y_b = nsa_attention(heads(qb, B_KV, B_REP), kvh(kbc, B_KV), kvh(vbc, B_KV), kvh(kbs, B_KV),
                        kvh(vbs, B_KV), kvh(kbw, B_KV), kvh(vbw, B_KV),
                        nsa_g.reshape(bsz, seq, B_KV, B_REP, 3), bias_b,
                        cmp_pos_k, cmp_w1_k, cmp_w2_k, cmp_pos_v, cmp_w1_v, cmp_w2_v)
    gate_a, gate_b = jnp.split(jax.nn.sigmoid(merge_g), 2, axis=-1)
    merged = (gate_a * (y_a.reshape(bsz, seq, A_WIDTH) @ w_branch_a)
              + gate_b * (y_b.reshape(bsz, seq, B_WIDTH) @ w_branch_b))
    return merged @ w_out


def moe_ffn(x2d, w_router, b_router, w_gate_up, b_gate_up, w_down, b_down):
    n_tok, d = x2d.shape
    logits = (x2d @ w_router + b_router).astype(jnp.float32)
    top_vals, top_idx = lax.top_k(logits, TOP_K)
    gates = jax.nn.softmax(top_vals, axis=-1)
    flat_e = top_idx.reshape(-1)
    n_assign = flat_e.shape[0]
    order = jnp.argsort(flat_e)
    sorted_e = flat_e[order]
    tok = order // TOP_K
    counts = jnp.bincount(flat_e, length=N_EXPERTS)
    padded = (counts + MOE_BLOCK - 1) // MOE_BLOCK * MOE_BLOCK
    start = jnp.cumsum(counts) - counts
    padded_end = jnp.cumsum(padded)
    padded_start = padded_end - padded
    dest = padded_start[sorted_e] + jnp.arange(n_assign) - start[sorted_e]
    n_blocks = -(-n_assign // MOE_BLOCK) + N_EXPERTS
    rows = jnp.zeros((n_blocks * MOE_BLOCK, d), x2d.dtype).at[dest].set(x2d[tok])
    block_expert = jnp.minimum(jnp.searchsorted(padded_end, jnp.arange(n_blocks) * MOE_BLOCK, side='right'), N_EXPERTS - 1)

    def expert_block(args):
        xb, e = args
        h = xb @ w_gate_up[e] + b_gate_up[e]
        glu = jnp.minimum(h[:, :D_FF], SWIGLU_LIMIT)
        lin = jnp.clip(h[:, D_FF:], -SWIGLU_LIMIT, SWIGLU_LIMIT)
        act = glu * jax.nn.sigmoid(SWIGLU_ALPHA * glu) * (lin + 1.0)
        return act @ w_down[e] + b_down[e]

    out_rows = lax.map(expert_block, (rows.reshape(n_blocks, MOE_BLOCK, d), block_expert))
    out_rows = out_rows.reshape(n_blocks * MOE_BLOCK, d)
    weights = gates.reshape(-1)[order].astype(x2d.dtype)
    return jnp.zeros_like(x2d).at[tok].add(out_rows[dest] * weights[:, None])


def setup_inputs(seed: int = 0) -> dict:
    key = jax.random.key(seed)
    ks = jax.random.split(key, 24)

    def nrm(k, shape, scale):
        return jax.random.normal(k, shape, jnp.float32) * scale

    L = DEPTH
    fan_cmp = CMP_LEN * HEAD_DIM
    return {
        'x': nrm(ks[0], (BATCH, SEQ, D_MODEL), 1.0),
        'w_in': nrm(ks[1], (L, D_MODEL, IN_WIDTH), D_MODEL ** -0.5),
        'b_in': nrm(ks[2], (L, IN_WIDTH), 0.02),
        'rel_bias': nrm(ks[3], (N_BUCKETS, A_HEADS + B_HEADS), 0.3),
        'attn_sinks': nrm(ks[4], (L, A_HEADS), 0.5),
        'cmp_pos_k': nrm(ks[5], (L, CMP_LEN, HEAD_DIM), 0.1),
        'cmp_w1_k': nrm(ks[6], (L, fan_cmp, CMP_HIDDEN), fan_cmp ** -0.5),
        'cmp_w2_k': nrm(ks[7], (L, CMP_HIDDEN, HEAD_DIM), CMP_HIDDEN ** -0.5),
        'cmp_pos_v': nrm(ks[8], (L, CMP_LEN, HEAD_DIM), 0.1),
        'cmp_w1_v': nrm(ks[9], (L, fan_cmp, CMP_HIDDEN), fan_cmp ** -0.5),
        'cmp_w2_v': nrm(ks[10], (L, CMP_HIDDEN, HEAD_DIM), CMP_HIDDEN ** -0.5),
        'w_branch_a': nrm(ks[11], (L, A_WIDTH, D_MODEL), A_WIDTH ** -0.5),
        'w_branch_b': nrm(ks[12], (L, B_WIDTH, D_MODEL), B_WIDTH ** -0.5),
        'w_out': nrm(ks[13], (L, D_MODEL, D_MODEL), D_MODEL ** -0.5 * DEEPNORM_BETA),
        'ln1_g': 1.0 + nrm(ks[14], (L, D_MODEL), 0.05),
        'ln1_b': nrm(ks[15], (L, D_MODEL), 0.02),
        'w_router': nrm(ks[16], (L, D_MODEL, N_EXPERTS), D_MODEL ** -0.5),
        'b_router': nrm(ks[17], (L, N_EXPERTS), 0.01),
        'w_gate_up': nrm(ks[18], (L, N_EXPERTS, D_MODEL, 2 * D_FF), D_MODEL ** -0.5),
        'b_gate_up': nrm(ks[19], (L, N_EXPERTS, 2 * D_FF), 0.02),
        'w_down': nrm(ks[20], (L, N_EXPERTS, D_FF, D_MODEL), D_FF ** -0.5 * DEEPNORM_BETA),
        'b_down': nrm(ks[21], (L, N_EXPERTS, D_MODEL), 0.02),
        'ln2_g': 1.0 + nrm(ks[22], (L, D_MODEL), 0.05),
        'ln2_b': nrm(ks[23], (L, D_MODEL), 0.02),
    }


def reference(x, w_in, b_in, rel_bias, attn_sinks, cmp_pos_k, cmp_w1_k, cmp_w2_k,
              cmp_pos_v, cmp_w1_v, cmp_w2_v, w_branch_a, w_branch_b, w_out, ln1_g, ln1_b,
              w_router, b_router, w_gate_up, b_gate_up, w_down, b_down, ln2_g, ln2_b):
    bsz, seq, d = x.shape
    h = x
    for l in range(DEPTH):
        mix = hybrid_mixer(h, w_in[l], b_in[l], rel_bias, attn_sinks[l], cmp_pos_k[l], cmp_w1_k[l],
                           cmp_w2_k[l], cmp_pos_v[l], cmp_w1_v[l], cmp_w2_v[l], w_branch_a[l],
                           w_branch_b[l], w_out[l])
        h = layer_norm(DEEPNORM_ALPHA * h + mix, ln1_g[l], ln1_b[l])
        ffn = moe_ffn(h.reshape(bsz * seq, d), w_router[l], b_router[l], w_gate_up[l],
                      b_gate_up[l], w_down[l], b_down[l]).reshape(bsz, seq, d)
        h = layer_norm(DEEPNORM_ALPHA * h + ffn, ln2_g[l], ln2_b[l])
    return h
```

```cpp
#include <hip/hip_runtime.h>
#include <cstdio>
#include <cstdint>
#include <type_traits>

#ifndef MK_ONE_LAUNCH
#define MK_ONE_LAUNCH 1
#endif

#define LAS __attribute__((address_space(3)))
#define GAS __attribute__((address_space(1)))
typedef unsigned short bf16_t;
typedef short bf16x8 __attribute__((ext_vector_type(8)));
typedef short s16x4 __attribute__((ext_vector_type(4)));
typedef float f32x2 __attribute__((ext_vector_type(2)));
typedef float f32x4 __attribute__((ext_vector_type(4)));
typedef float f32x16 __attribute__((ext_vector_type(16)));
typedef unsigned u32x2 __attribute__((ext_vector_type(2)));
typedef unsigned u32x4 __attribute__((ext_vector_type(4)));
typedef int i32x4 __attribute__((ext_vector_type(4)));
typedef int i32x8 __attribute__((ext_vector_type(8)));
typedef __bf16 bf16x2_t __attribute__((ext_vector_type(2)));

constexpr int BATCH = 32, SEQ = 2048, DM = 1024, T = BATCH * SEQ;
constexpr int NE = 32, DFF = 1024;
constexpr int NPROJ = 4352;
constexpr int HALF_T = T;
constexpr int LIST_CAP = HALF_T;
constexpr int MAX_RT = 1056;
constexpr float LN_EPS = 1e-5f;
constexpr float ALPHA = 1.189207115002721f;
constexpr float LOG2E = 1.4426950408889634f;
constexpr float C2 = 0.125f * LOG2E;
constexpr int NWAVES = 8;

constexpr size_t MiB = (size_t)1 << 20;
constexpr size_t WS_CTL = 0, CTL_ZERO_BYTES = 1 * MiB;
constexpr size_t WS_LIST = 1 * MiB;
constexpr size_t WS_TOKSLOT = 9 * MiB;
constexpr size_t WS_TOKGATE = 10 * MiB;
constexpr size_t WS_BINP = 11 * MiB;
constexpr size_t WS_B1 = 11 * MiB + 32 * 1024;
constexpr size_t WS_XS = 11 * MiB + 64 * 1024;
constexpr size_t WS_WSIN = 11 * MiB + 512 * 1024;
constexpr size_t WS_WSGU = 11 * MiB + 768 * 1024;
constexpr size_t WS_WSDN = 14 * MiB + 512 * 1024;
constexpr size_t WS_WSAB = 14 * MiB + 768 * 1024;
constexpr size_t WS_HS = 14 * MiB;
constexpr size_t WS_KC = 12 * MiB;
constexpr size_t WS_VC = 13 * MiB;
constexpr size_t WS_WIN = 16 * MiB;
constexpr size_t WS_WAB = 25 * MiB;
constexpr size_t WS_WOUT = 27 * MiB;
constexpr size_t WS_CW1 = 29 * MiB;
constexpr size_t WS_CW2 = 30 * MiB;
constexpr size_t WS_WGU = 32 * MiB;
constexpr size_t WS_WDN = 160 * MiB;
constexpr size_t WS_H = 224 * MiB;
constexpr size_t WS_D = 352 * MiB;
constexpr size_t WS_XB = WS_D;
constexpr size_t WS_Y = WS_D;
constexpr size_t WS_QA = WS_D + 128 * MiB;
constexpr size_t WS_KVA = WS_D + 192 * MiB;
constexpr size_t WS_QB = WS_D + 224 * MiB;
constexpr size_t WS_KVC = WS_D + 288 * MiB;
constexpr size_t WS_MG = WS_D + 384 * MiB;
constexpr size_t WS_NG = WS_D + 640 * MiB;
constexpr size_t WS_MERGED = WS_D + 128 * MiB;
constexpr size_t WS_ACT = WS_D;
constexpr size_t WS_OUTROWS = WS_D + 264 * MiB;
constexpr size_t WS_HQ = WS_D + 544 * MiB;
constexpr size_t WS_LSCALE = WS_D + 608 * MiB;
constexpr size_t WS_END = WS_D + 672 * MiB;
static_assert(WS_NG + (size_t)T * 32 * 2 <= WS_END && WS_OUTROWS + 264 * MiB <= WS_HQ, "ws map");
constexpr int CW_BAR = 4096;
constexpr int CW_CNT = 16384;

constexpr int LDS_BYTES = 151552;
constexpr int LDSCTL_OFF = 132096;
constexpr int MISC_OFF = LDSCTL_OFF;
constexpr int TAB_PST = LDSCTL_OFF + 256;
constexpr int TAB_CNT = TAB_PST + 160;
constexpr int TAB_TILE = TAB_CNT + 128;
constexpr int SIDE_OFF = 139264;
static_assert(TAB_TILE + MAX_RT * 4 <= SIDE_OFF && SIDE_OFF + 3 * 4096 <= LDS_BYTES, "lds map");

#define LDS_WAIT() asm volatile("s_waitcnt lgkmcnt(0)" ::: "memory")
#define VM_WAIT() asm volatile("s_waitcnt vmcnt(0)" ::: "memory")
#define RLX_AGENT __ATOMIC_RELAXED, __HIP_MEMORY_SCOPE_AGENT

__device__ __forceinline__ unsigned pk2(float lo, float hi) { f32x2 v = {lo, hi}; bf16x2_t b = __builtin_convertvector(v, bf16x2_t); return __builtin_bit_cast(unsigned, b); }
__device__ __forceinline__ unsigned pk4(float a, float b, float c, float d) {
    return ((unsigned)(int)a & 255u) | (((unsigned)(int)b & 255u) << 8) | (((unsigned)(int)c & 255u) << 16) | ((unsigned)(int)d << 24); }
__device__ __forceinline__ unsigned pk4u(float a, float b, float c, float d) {
    return (unsigned)(int)a | ((unsigned)(int)b << 8) | ((unsigned)(int)c << 16) | ((unsigned)(int)d << 24); }
__device__ __forceinline__ float bflo(unsigned w) { return __uint_as_float(w << 16); }
__device__ __forceinline__ float bfhi(unsigned w) { return __uint_as_float(w & 0xffff0000u); }
__device__ __forceinline__ float fsigmoid(float x) { return __builtin_amdgcn_rcpf(1.0f + __builtin_amdgcn_exp2f(-x * LOG2E)); }
template <int CTRL, int RMASK> __device__ __forceinline__ float dpp_f(float old, float v) {
    return __uint_as_float((unsigned)__builtin_amdgcn_update_dpp((int)__float_as_uint(old), (int)__float_as_uint(v), CTRL, RMASK, 0xf, false)); }
__device__ __forceinline__ float wave_sum(float v) {
    v += dpp_f<0xB1, 0xf>(v, v); v += dpp_f<0x4E, 0xf>(v, v); v += dpp_f<0x141, 0xf>(v, v); v += dpp_f<0x140, 0xf>(v, v);
    v += dpp_f<0x142, 0xa>(0.f, v); v += dpp_f<0x143, 0xc>(0.f, v);
    return __uint_as_float((unsigned)__builtin_amdgcn_readlane((int)__float_as_uint(v), 63));
}
__device__ __forceinline__ float wave_max_nonneg(float v) {
    v = fmaxf(v, dpp_f<0xB1, 0xf>(v, v)); v = fmaxf(v, dpp_f<0x4E, 0xf>(v, v)); v = fmaxf(v, dpp_f<0x141, 0xf>(v, v)); v = fmaxf(v, dpp_f<0x140, 0xf>(v, v));
    v = fmaxf(v, dpp_f<0x142, 0xa>(0.f, v)); v = fmaxf(v, dpp_f<0x143, 0xc>(0.f, v));
    return __uint_as_float((unsigned)__builtin_amdgcn_readlane((int)__float_as_uint(v), 63));
}

#define XB_TMO      128
#define XB_XCNT(j)  (256  + 64 * (j))
#define XB_XSUB(j)  (1280 + 64 * (j))
#define XB_XGEN(j)  (2304 + 64 * (j))
#define XB_TOP      3328
#define XB_TOPGEN   3392
#define XCD_BAR_WORDS 3456
#define XB_SPIN_CAP (1u << 18)
__device__ __forceinline__ unsigned xb_ld(unsigned* p)              { return __hip_atomic_load(p, __ATOMIC_RELAXED, __HIP_MEMORY_SCOPE_AGENT); }
__device__ __forceinline__ unsigned xb_add(unsigned* p, unsigned v) { return __hip_atomic_fetch_add(p, v, __ATOMIC_RELAXED, __HIP_MEMORY_SCOPE_AGENT); }
__device__ __forceinline__ unsigned xb_xcc_id() { return (unsigned)__builtin_amdgcn_s_getreg((3 << 11) | 20) & 0xFu; }
#define XB_SPIN(cond, bar) do { unsigned _sp = 0; while (cond) { __builtin_amdgcn_s_sleep(1); \
    if ((++_sp & 255u) == 0u) { if (xb_ld(&(bar)[XB_TMO])) break; if (_sp > XB_SPIN_CAP) { atomicAdd(&(bar)[XB_TMO], 1u); break; } } } } while (0)
struct XcdBarrier { unsigned* bar; unsigned x; volatile LAS unsigned* st; };
__device__ __forceinline__ XcdBarrier xcd_barrier_post(unsigned* bar, volatile LAS unsigned* st) {
    XcdBarrier b; b.bar = bar; b.x = xb_xcc_id(); b.st = st;
    if (threadIdx.x == 0) (void)xb_add(&bar[XB_XCNT(b.x)], 1u);
    return b;
}
__device__ __forceinline__ void xcd_barrier_complete(unsigned* bar, unsigned x, unsigned& nloc, unsigned& nx) {
    const unsigned G = gridDim.x * gridDim.y * gridDim.z;
    unsigned sum, cnt, mine, sp = 0u;
    for (;;) {
        sum = 0u; cnt = 0u; mine = 0u;
#pragma unroll
        for (unsigned j = 0; j < 16; ++j) { const unsigned c = xb_ld(&bar[XB_XCNT(j)]); sum += c; cnt += (c > 0u) ? 1u : 0u; mine = (j == x) ? c : mine; }
        if (sum == G) break;
        __builtin_amdgcn_s_sleep(1);
        if ((++sp & 255u) == 0u) { if (xb_ld(&bar[XB_TMO])) break; if (sp > XB_SPIN_CAP) { atomicAdd(&bar[XB_TMO], 1u); break; } }
    }
    nloc = mine > 0u ? mine : 1u; nx = cnt > 0u ? cnt : 1u;
}
__device__ __forceinline__ void xcd_barrier(const XcdBarrier& b) {
    asm volatile("s_waitcnt vmcnt(0)" ::: "memory");
    __syncthreads();
    if (threadIdx.x == 0) {
        unsigned* bar = b.bar;
        __builtin_amdgcn_s_waitcnt(0);
        unsigned nloc = b.st[0], nx = b.st[1];
        if (nloc == 0u) { xcd_barrier_complete(bar, b.x, nloc, nx); b.st[0] = nloc; b.st[1] = nx; }
        const unsigned old = xb_add(&bar[XB_XSUB(b.x)], 1u);
        const unsigned gen = old / nloc;
        if (old + 1u == (gen + 1u) * nloc) {
            __builtin_amdgcn_fence(__ATOMIC_RELEASE, "agent");
            asm volatile("s_waitcnt vmcnt(0)" ::: "memory");
            const unsigned og = xb_add(&bar[XB_TOP], 1u);
            const unsigned tg = og / nx;
            if (og + 1u == (tg + 1u) * nx) xb_add(&bar[XB_TOPGEN], 1u);
            else XB_SPIN(xb_ld(&bar[XB_TOPGEN]) == tg, bar);
            __builtin_amdgcn_fence(__ATOMIC_ACQUIRE, "agent");
            xb_add(&bar[XB_XGEN(b.x)], 1u);
            asm volatile("s_waitcnt vmcnt(0)" ::: "memory");
        } else {
            XB_SPIN(xb_ld(&bar[XB_XGEN(b.x)]) == gen, bar);
            __builtin_amdgcn_fence(__ATOMIC_ACQUIRE, "agent");
            asm volatile("s_waitcnt vmcnt(0)" ::: "memory");
        }
    }
    __syncthreads();
}

namespace pg8 {
constexpr int BM = 256, BK = 64, HALF = 128, HTB = HALF * BK * 2, STAGE_BYTES = 8 * HTB, NXCD = 8, WGM = 8;
__host__ __device__ __forceinline__ int lds_byte(int r, int c) { const int st = (r >> 4) * 2 + (c >> 5), rr = r & 15, cc = c & 31, ob = rr * 64 + cc * 2; return st * 1024 + (ob ^ (((ob >> 9) & 1) << 5)); }
__host__ __device__ __forceinline__ void stage_rc(int b, int& R, int& C) { const int st = b / 1024, sb = b % 1024, swz = sb ^ (((sb >> 9) & 1) << 5); R = (st >> 1) * 16 + swz / 64; C = (st & 1) * 32 + (swz % 64) / 2; }
__host__ __device__ __forceinline__ int perm32(int rho) { const int n = rho >> 4, i = rho & 15; return 8 * (i >> 2) + 4 * n + (i & 3); }

__host__ __device__ __forceinline__ int perm_wide(int R) { const int bj = R >> 7, wc = (R >> 5) & 3, n = (R >> 4) & 1, fq = (R >> 2) & 3, j = R & 3; return wc * 64 + fq * 16 + bj * 8 + n * 4 + j; }
struct Unit { int pm, pn, e; };
__device__ __forceinline__ u32x4 pair_rows16(const u32x2 X, const u32x2 Y) {
    const auto rx = __builtin_amdgcn_permlane16_swap(X.x, Y.x, false, false), ry = __builtin_amdgcn_permlane16_swap(X.y, Y.y, false, false);
    u32x4 w; w.x = rx[0]; w.y = ry[0]; w.z = rx[1]; w.w = ry[1]; return w; }

struct StaticOrder {
    int nM, nN, nwg, G, c;
    __device__ void init(int nM_, int nN_, int G_, int c_) { nM = nM_; nN = nN_; nwg = nM * nN; G = G_; c = c_; }
    __device__ __forceinline__ bool next(int i, Unit& u) const {
        const long L = (long)i * G + c; if (L >= nwg) return false;
        int wgid = (int)L; { const int q = nwg / NXCD, r = nwg % NXCD, xcd = wgid % NXCD, off = wgid / NXCD; wgid = (xcd < r ? xcd * (q + 1) : r * (q + 1) + (xcd - r) * q) + off; }
        const int nig = WGM * nN, gid = wgid / nig, fm = gid * WGM, gsz = (nM - fm) < WGM ? (nM - fm) : WGM;
        u.pm = fm + ((wgid % nig) % gsz); u.pn = (wgid % nig) / gsz; u.e = 0; return true;
    }
};
struct MoeOrder : StaticOrder {
    const LAS int* tile_e;
    __device__ __forceinline__ bool next(int i, Unit& u) const {
        if (!StaticOrder::next(i, u)) return false;
        u.e = __builtin_amdgcn_readfirstlane(tile_e[u.pm]); return true;
    }
};
struct APlain { const char* base; unsigned ldab;
    static constexpr bool GATHER = false; static constexpr size_t KSTEP = BK * 2;
    static __device__ __forceinline__ unsigned coloff(unsigned cb) { return cb; }
    __device__ __forceinline__ const int* gptr(const Unit&, int) const { return nullptr; }
    __device__ __forceinline__ unsigned rowoff(const Unit& u, int r, const LAS int*) const { return (unsigned)(u.pm * BM + r) * ldab; } };
struct AGather { const char* base; const int* list; const LAS int* pst; const LAS int* cnt;
    static constexpr bool GATHER = true; static constexpr size_t KSTEP = BK * 2;
    static __device__ __forceinline__ unsigned coloff(unsigned cb) { return cb; }
    __device__ __forceinline__ const int* gptr(const Unit& u, int tid) const {
        int lr = (u.pm - pst[u.e]) * BM + (tid & 255); if (lr >= cnt[u.e]) lr = 0; return list + (size_t)u.e * LIST_CAP + lr; }
    __device__ __forceinline__ unsigned rowoff(const Unit&, int r, const LAS int* stok) const { return (unsigned)stok[r] * 1024u; } };
__host__ __device__ __forceinline__ size_t bl32_off(int row, int col) { return (size_t)(row >> 8) * 262144 + (size_t)(col >> 5) * 8192 + (size_t)(row & 255) * 32 + (col & 31); }
struct ABlk32 { const char* base;
    static constexpr bool GATHER = false; static constexpr size_t KSTEP = 4 * 8192;
    static __device__ __forceinline__ unsigned coloff(unsigned cb) { return (cb >> 5) * 8192u + (cb & 31u); }
    __device__ __forceinline__ const int* gptr(const Unit&, int) const { return nullptr; }
    __device__ __forceinline__ unsigned rowoff(const Unit& u, int r, const LAS int*) const { return (unsigned)u.pm * 262144u + (unsigned)r * 32u; } };
struct BPlain { const char* base; int ldbb  ; size_t estride;
    __device__ __forceinline__ const char* tile(const Unit& u) const { return base + (size_t)u.e * estride + (size_t)u.pn * BM * ldbb; } };
__device__ __forceinline__ f32x4 tof(const f32x4& v) { return v; }
__device__ __forceinline__ f32x4 tof(const i32x4& v) { return __builtin_convertvector(v, f32x4); }

__device__ __forceinline__ unsigned cvt_pk_bf16(float lo, float hi) { return pk2(lo, hi); }

template <class AP, class BP, class Epi, class Sched, bool ALIGN_EPI, bool SP2, int MODE = 0  >
__device__ __forceinline__ void gemm_phase(LAS unsigned char* lds, const AP& A, const BP& B, const int nt  , const Sched& S, const Epi& E) {
    const int tid = threadIdx.x, wid = __builtin_amdgcn_readfirstlane(tid >> 6), lane = tid & 63, wr = wid >> 2, wc = wid & 3, fr = lane & 15, fq = lane >> 4;
    int Rst[2], Cst[2]; unsigned voffB[2];
#pragma unroll
    for (int i = 0; i < 2; ++i) { int R, C; stage_rc(tid * 16 + i * 8192, R, C); Rst[i] = R; Cst[i] = C; const int Rb = (int)Epi::PERM == 2 ? perm_wide(R) : Epi::PERM ? ((R & ~31) + perm32(R & 31)) : R;
        voffB[i] = (unsigned)(Rb * B.ldbb + C * 2); }
    const size_t kstep = (size_t)(BK * 2), kstepA = AP::KSTEP;
    const size_t hstepB = (size_t)((int)Epi::PERM == 2 ? 8 : HALF) * B.ldbb;
    const unsigned ldsw = (unsigned)wid * 1024u;
    const int aoff = lds_byte(wr * 64 + fr, fq * 8), boff = lds_byte(wc * 32 + fr, fq * 8);
#define PG8_SA(b, h) (((b) * 2 + (h)) * HTB)
#define PG8_SB(b, h) ((4 + (b) * 2 + (h)) * HTB)
#define PG8_STAGE(bufoff, gbase, voff) do { _Pragma("unroll") for (int _i = 0; _i < 2; ++_i) \
        __builtin_amdgcn_global_load_lds((const unsigned*)((const char*)(gbase) + (voff)[_i]), (LAS unsigned*)(lds + (bufoff) + ldsw + _i * 8192), 16, 0, 0); } while (0)
#define PG8_LDA(dst, b, h) do { _Pragma("unroll") for (int m = 0; m < 4; ++m) _Pragma("unroll") for (int k = 0; k < 2; ++k) dst[m][k] = *(const LAS bf16x8*)(lds + PG8_SA(b, h) + aoff + m * 2048 + k * 1024); } while (0)
#define PG8_LDB(dst, b, h) do { _Pragma("unroll") for (int n = 0; n < 2; ++n) _Pragma("unroll") for (int k = 0; k < 2; ++k) dst[n][k] = *(const LAS bf16x8*)(lds + PG8_SB(b, h) + boff + n * 2048 + k * 1024); } while (0)
#define PG8_MMA(ai, bj, At, Bt) do { __builtin_amdgcn_s_setprio(1); _Pragma("unroll") for (int m = 0; m < 4; ++m) _Pragma("unroll") for (int n = 0; n < 2; ++n) { \
        if constexpr (MODE == 2) {   \
            const i32x8 bw = __builtin_shufflevector(__builtin_bit_cast(i32x4, Bt[n][0]), __builtin_bit_cast(i32x4, Bt[n][1]), 0, 1, 2, 3, 4, 5, 6, 7); \
            const i32x8 aw = __builtin_shufflevector(__builtin_bit_cast(i32x4, At[m][0]), __builtin_bit_cast(i32x4, At[m][1]), 0, 1, 2, 3, 4, 5, 6, 7); \
            asm volatile("s_nop 1\n\tv_mfma_scale_f32_16x16x128_f8f6f4 %0, %1, %2, %0, %3, %3 op_sel_hi:[0,0,0]" : "+v"(acc[ai][bj][m][n]) : "v"(bw), "v"(aw), "v"(mxsc)); \
        } else { _Pragma("unroll") for (int k = 0; k < 2; ++k) { \
        if constexpr (MODE == 1) acc[ai][bj][m][n] = __builtin_bit_cast(AccV, __builtin_amdgcn_mfma_i32_16x16x64_i8(__builtin_bit_cast(i32x4, Bt[n][k]), __builtin_bit_cast(i32x4, At[m][k]), __builtin_bit_cast(i32x4, acc[ai][bj][m][n]), 0, 0, 0)); \
        else acc[ai][bj][m][n] = __builtin_bit_cast(AccV, __builtin_amdgcn_mfma_f32_16x16x32_bf16(Bt[n][k], At[m][k], __builtin_bit_cast(f32x4, acc[ai][bj][m][n]), 0, 0, 0)); } } } __builtin_amdgcn_s_setprio(0); } while (0)
#define PG8_WAIT_V(n) asm volatile("s_waitcnt vmcnt(" #n ")" ::: "memory")
#define PG8_WAIT_L(n) asm volatile("s_waitcnt lgkmcnt(" #n ")" ::: "memory")
#define PG8_BAR __builtin_amdgcn_s_barrier()
#define PG8_SCHED __builtin_amdgcn_sched_barrier(0)
    Unit cur, nxt; int ui = 0;
    if (!S.next(0, cur)) return;
    typedef typename std::conditional<MODE == 1, i32x4, f32x4>::type AccV;
    AccV acc[2][2][4][2];
#pragma unroll
    for (int a = 0; a < 2; ++a)
#pragma unroll
        for (int b = 0; b < 2; ++b)
#pragma unroll
            for (int m = 0; m < 4; ++m)
#pragma unroll
                for (int n = 0; n < 2; ++n) acc[a][b][m][n] = (AccV){0, 0, 0, 0};
    bf16x8 At[4][2], B0[2][2], B1[2][2];
    const unsigned mxsc = 0x7f7f7f7fu;
    unsigned aoC0[2], aoC1[2], aoN0[2], aoN1[2];
    const char* const Ab = A.base;
    const char* cB = B.tile(cur);
    LAS float* const side = (LAS float*)(lds + SIDE_OFF);
    int sbuf = 0;
#define PG8_SIDE(unit, buf) do { if constexpr (Epi::SIDE) { \
        __builtin_amdgcn_global_load_lds((const unsigned*)E.side_ptr0(unit, tid), (LAS unsigned*)(lds + SIDE_OFF + (buf) * 4096 + wid * 256), 4, 0, 0); \
        if (wid < 4) __builtin_amdgcn_global_load_lds((const unsigned*)E.side_ptr1(unit, tid), (LAS unsigned*)(lds + SIDE_OFF + (buf) * 4096 + 2048 + wid * 256), 4, 0, 0); } \
        if constexpr (AP::GATHER) { if (wid < 4) __builtin_amdgcn_global_load_lds((const unsigned*)A.gptr(unit, tid), (LAS unsigned*)(lds + SIDE_OFF + (buf) * 4096 + 3072 + wid * 256), 4, 0, 0); } } while (0)
    PG8_SIDE(cur, 0);
    if constexpr (AP::GATHER) { PG8_WAIT_V(0); PG8_BAR; }
#pragma unroll
    for (int i = 0; i < 2; ++i) { const LAS int* stok = (const LAS int*)(side + 768); aoC0[i] = A.rowoff(cur, Rst[i], stok) + AP::coloff((unsigned)Cst[i] * 2u); aoC1[i] = A.rowoff(cur, HALF + Rst[i], stok) + AP::coloff((unsigned)Cst[i] * 2u); }
    if constexpr (SP2) {
        PG8_STAGE(PG8_SB(0, 0), cB, voffB); PG8_STAGE(PG8_SB(0, 1), cB + hstepB, voffB); PG8_STAGE(PG8_SA(0, 0), Ab, aoC0); PG8_STAGE(PG8_SA(0, 1), Ab, aoC1);
        if (wr == 1) PG8_BAR;
        PG8_WAIT_V(2); PG8_BAR;
        PG8_STAGE(PG8_SB(1, 0), cB + kstep, voffB); PG8_STAGE(PG8_SA(1, 0), Ab + kstepA, aoC0); PG8_STAGE(PG8_SB(1, 1), cB + hstepB + kstep, voffB);
        PG8_WAIT_V(6); PG8_BAR;
    } else {
        PG8_STAGE(PG8_SB(0, 0), cB, voffB); PG8_STAGE(PG8_SA(0, 0), Ab, aoC0); PG8_STAGE(PG8_SB(0, 1), cB + hstepB, voffB); PG8_STAGE(PG8_SA(0, 1), Ab, aoC1);
        if (wr == 1) PG8_BAR;
        PG8_WAIT_V(4); PG8_BAR;
        PG8_STAGE(PG8_SB(1, 0), cB + kstep, voffB); PG8_STAGE(PG8_SA(1, 0), Ab + kstepA, aoC0); PG8_STAGE(PG8_SB(1, 1), cB + hstepB + kstep, voffB);
        PG8_WAIT_V(6); PG8_BAR;
    }
    for (;;) {
        const bool has_next = S.next(ui + 1, nxt);
        const char* nB = has_next ? B.tile(nxt) : cB;
        const int nbuf = sbuf == 2 ? 0 : sbuf + 1;
        if (has_next) PG8_SIDE(nxt, nbuf);
        if (has_next) {
            if constexpr (!AP::GATHER) {
#pragma unroll
            for (int i = 0; i < 2; ++i) { aoN0[i] = A.rowoff(nxt, Rst[i], nullptr) + AP::coloff((unsigned)Cst[i] * 2u); aoN1[i] = A.rowoff(nxt, HALF + Rst[i], nullptr) + AP::coloff((unsigned)Cst[i] * 2u); } }
        } else {
#pragma unroll
            for (int i = 0; i < 2; ++i) { aoN0[i] = aoC0[i]; aoN1[i] = aoC1[i]; }
        }
#pragma nounroll
        for (int t = 0; t < nt; t += 2) {
            const bool last = (t == nt - 2);
            const char* a1 = Ab + (size_t)(t + 1) * kstepA;
            const char* a2 = last ? Ab : Ab + (size_t)(t + 2) * kstepA; const char* b2 = last ? nB : cB + (size_t)(t + 2) * kstep;
            const char* a3 = a2 + kstepA; const char* b3 = b2 + kstep;
            if constexpr (AP::GATHER) { if (last && has_next) {
                const LAS int* stok = (const LAS int*)(side + nbuf * 1024 + 768);
#pragma unroll
                for (int i = 0; i < 2; ++i) { aoN0[i] = A.rowoff(nxt, Rst[i], stok) + AP::coloff((unsigned)Cst[i] * 2u); aoN1[i] = A.rowoff(nxt, HALF + Rst[i], stok) + AP::coloff((unsigned)Cst[i] * 2u); } } }
            unsigned s0[2], s1[2];
#pragma unroll
            for (int i = 0; i < 2; ++i) { s0[i] = last ? aoN0[i] : aoC0[i]; s1[i] = last ? aoN1[i] : aoC1[i]; }
            if constexpr (SP2) {
            PG8_LDB(B0, 0, 0); PG8_LDB(B1, 0, 1); PG8_SCHED; PG8_LDA(At, 0, 0); PG8_STAGE(PG8_SA(1, 1), a1, aoC1);
            PG8_WAIT_V(8); PG8_WAIT_L(0); PG8_BAR; PG8_MMA(0, 0, At, B0); PG8_MMA(0, 1, At, B1); PG8_BAR; PG8_SCHED;
            PG8_LDA(At, 0, 1); PG8_STAGE(PG8_SB(0, 0), b2, voffB); PG8_STAGE(PG8_SB(0, 1), b2 + hstepB, voffB); PG8_STAGE(PG8_SA(0, 0), a2, s0);
            PG8_WAIT_V(8); PG8_WAIT_L(0); PG8_BAR; PG8_MMA(1, 0, At, B0); PG8_MMA(1, 1, At, B1); PG8_BAR; PG8_SCHED;
            PG8_LDB(B0, 1, 0); PG8_LDB(B1, 1, 1); PG8_SCHED; PG8_LDA(At, 1, 0); PG8_STAGE(PG8_SA(0, 1), a2, s1);
            PG8_WAIT_V(8); PG8_WAIT_L(0); PG8_BAR; PG8_MMA(0, 0, At, B0); PG8_MMA(0, 1, At, B1); PG8_BAR; PG8_SCHED;
            PG8_LDA(At, 1, 1); PG8_STAGE(PG8_SB(1, 0), b3, voffB); PG8_STAGE(PG8_SB(1, 1), b3 + hstepB, voffB); PG8_STAGE(PG8_SA(1, 0), a3, s0);
            PG8_WAIT_V(8); PG8_WAIT_L(0); PG8_BAR; PG8_MMA(1, 0, At, B0); PG8_MMA(1, 1, At, B1); PG8_BAR; PG8_SCHED;
            } else {
            PG8_LDB(B0, 0, 0); PG8_SCHED; PG8_LDA(At, 0, 0); PG8_STAGE(PG8_SA(1, 1), a1, aoC1);
            PG8_WAIT_L(8); PG8_BAR; PG8_WAIT_L(0); PG8_MMA(0, 0, At, B0); PG8_BAR; PG8_SCHED;
            PG8_LDB(B1, 0, 1); PG8_STAGE(PG8_SB(0, 0), b2, voffB);
            PG8_BAR; PG8_WAIT_L(0); PG8_MMA(0, 1, At, B1); PG8_BAR;
            PG8_LDA(At, 0, 1); PG8_STAGE(PG8_SA(0, 0), a2, s0);
            PG8_BAR; PG8_WAIT_L(0); PG8_MMA(1, 0, At, B0); PG8_BAR; PG8_SCHED;
            PG8_STAGE(PG8_SB(0, 1), b2 + hstepB, voffB);
            PG8_WAIT_V(6); PG8_BAR; PG8_MMA(1, 1, At, B1); PG8_BAR;
            PG8_LDB(B0, 1, 0); PG8_SCHED; PG8_LDA(At, 1, 0); PG8_STAGE(PG8_SA(0, 1), a2, s1);
            PG8_WAIT_L(8); PG8_BAR; PG8_WAIT_L(0); PG8_MMA(0, 0, At, B0); PG8_BAR; PG8_SCHED;
            PG8_LDB(B1, 1, 1); PG8_STAGE(PG8_SB(1, 0), b3, voffB);
            PG8_BAR; PG8_WAIT_L(0); PG8_MMA(0, 1, At, B1); PG8_BAR;
            PG8_LDA(At, 1, 1); PG8_STAGE(PG8_SA(1, 0), a3, s0);
            PG8_BAR; PG8_WAIT_L(0); PG8_MMA(1, 0, At, B0); PG8_BAR; PG8_SCHED;
            PG8_STAGE(PG8_SB(1, 1), b3 + hstepB, voffB);
            PG8_WAIT_V(6); PG8_BAR; PG8_MMA(1, 1, At, B1); PG8_BAR;
            }
        }
        if constexpr (MODE == 2) asm volatile("s_nop 15\n\ts_nop 7" ::: "memory");
        if constexpr (ALIGN_EPI) { if (wr == 0) PG8_BAR; }
        E(acc, cur, wr, wc, fr, fq, side + sbuf * 1024);
        if (!has_next) break;
#pragma unroll
        for (int a = 0; a < 2; ++a)
#pragma unroll
            for (int b = 0; b < 2; ++b)
#pragma unroll
                for (int m = 0; m < 4; ++m)
#pragma unroll
                    for (int n = 0; n < 2; ++n) acc[a][b][m][n] = (AccV){0, 0, 0, 0};
        cur = nxt; cB = nB; ++ui; sbuf = nbuf;
#pragma unroll
        for (int i = 0; i < 2; ++i) { aoC0[i] = aoN0[i]; aoC1[i] = aoN1[i]; }
        if constexpr (ALIGN_EPI) { if (wr == 1) PG8_BAR; }
    }
    PG8_WAIT_V(0);
    if constexpr (!ALIGN_EPI) { if (wr == 0) PG8_BAR; }
    PG8_BAR;
#undef PG8_SIDE
#undef PG8_SA
#undef PG8_SB
#undef PG8_STAGE
#undef PG8_LDA
#undef PG8_LDB
#undef PG8_MMA
#undef PG8_WAIT_V
#undef PG8_WAIT_L
#undef PG8_BAR
#undef PG8_SCHED
}


struct EpiProj {
    static constexpr bool PERM = true, SIDE = true;
    __device__ __forceinline__ const float* side_ptr0(const Unit& u, int tid) const { return (tid < 256 ? bias : wsc) + u.pn * 256 + (tid & 255); }
    __device__ __forceinline__ const float* side_ptr1(const Unit& u, int tid) const { return xs + u.pm * BM + (tid & 255); }
    unsigned char* ws; const float* bias; const float* xs; const float* wsc;
    template <class AV> __device__ __forceinline__ void operator()(const AV (&acc)[2][2][4][2], const Unit& u, int wr, int wc, int fr, int fq, const LAS float* sd) const {
        const int pn = u.pn; bf16_t* base; int ld, c0; bool ng = false; const bool gate8 = pn >= 8 && pn < 16;
        if (pn < 2) { base = (bf16_t*)(ws + WS_QA); ld = 512; c0 = pn * 256; }
        else if (pn == 2) { base = (bf16_t*)(ws + WS_KVA); ld = 256; c0 = 0; }
        else if (pn < 5) { base = (bf16_t*)(ws + WS_QB); ld = 512; c0 = (pn - 3) * 256; }
        else if (pn < 8) { base = (bf16_t*)(ws + WS_KVC + (size_t)(pn - 5) * 32 * MiB); ld = 256; c0 = 0; }
        else if (pn < 16) { base = (bf16_t*)(ws + WS_MG); ld = 2048; c0 = (pn - 8) * 256; }
        else { base = (bf16_t*)(ws + WS_NG); ld = 32; c0 = 0; ng = true; }
        const int row0 = u.pm * BM + wr * 64 + fr, ct = wc * 32 + 8 * fq;
        f32x4 bv[2][2], sv[2][2];
#pragma unroll
        for (int bj = 0; bj < 2; ++bj)
#pragma unroll
            for (int n = 0; n < 2; ++n) { bv[bj][n] = *(const LAS f32x4*)(sd + bj * HALF + ct + 4 * n); sv[bj][n] = *(const LAS f32x4*)(sd + 256 + bj * HALF + ct + 4 * n); }
        if (gate8) {
#pragma unroll
            for (int ai = 0; ai < 2; ++ai)
#pragma unroll
                for (int mp = 0; mp < 2; ++mp)
#pragma unroll
                    for (int bj = 0; bj < 2; ++bj) { u32x2 w8[2];
#pragma unroll
                        for (int mm = 0; mm < 2; ++mm) { const int m = 2 * mp + mm; const float rs = sd[512 + wr * 64 + fr + ai * HALF + m * 16];
                            const f32x4 v0 = tof(acc[ai][bj][m][0]) * (sv[bj][0] * rs) + bv[bj][0], v1 = tof(acc[ai][bj][m][1]) * (sv[bj][1] * rs) + bv[bj][1];
                            w8[mm].x = pk4u(fsigmoid(v0[0]) * 255.0f + 0.5f, fsigmoid(v0[1]) * 255.0f + 0.5f, fsigmoid(v0[2]) * 255.0f + 0.5f, fsigmoid(v0[3]) * 255.0f + 0.5f);
                            w8[mm].y = pk4u(fsigmoid(v1[0]) * 255.0f + 0.5f, fsigmoid(v1[1]) * 255.0f + 0.5f, fsigmoid(v1[2]) * 255.0f + 0.5f, fsigmoid(v1[3]) * 255.0f + 0.5f); }
                        const int row = row0 + ai * HALF + (2 * mp + (fq & 1)) * 16;
                        *(u32x4*)((unsigned char*)(ws + WS_MG) + (size_t)row * 2048 + c0 + wc * 32 + 8 * (fq & 2) + bj * HALF) = pair_rows16(w8[0], w8[1]); }
        } else {
#pragma unroll
        for (int ai = 0; ai < 2; ++ai)
#pragma unroll
            for (int m = 0; m < 4; ++m) { const int row = row0 + ai * HALF + m * 16; const float rs = sd[512 + wr * 64 + fr + ai * HALF + m * 16]; bf16_t* rowp = base + (size_t)row * ld + c0 + ct;
#pragma unroll
                for (int bj = 0; bj < 2; ++bj) { const f32x4 v0 = tof(acc[ai][bj][m][0]) * (sv[bj][0] * rs) + bv[bj][0], v1 = tof(acc[ai][bj][m][1]) * (sv[bj][1] * rs) + bv[bj][1];
                    u32x4 w; w.x = pk2(v0[0], v0[1]); w.y = pk2(v0[2], v0[3]); w.z = pk2(v1[0], v1[1]); w.w = pk2(v1[2], v1[3]);
                    if (!ng || (bj == 0 && wc == 0)) *(u32x4*)(rowp + bj * HALF) = w; } }
        }
    }
};
struct EpiSwiglu {
    static constexpr bool PERM = true, SIDE = true;
    __device__ __forceinline__ const float* side_ptr0(const Unit& u, int tid) const {
        const float* bg = bgu + (size_t)u.e * 2048 + 128 * u.pn;
        return tid < 128 ? bg + tid : tid < 256 ? bg + 1024 + (tid - 128) : wsc + (size_t)u.e * 2048 + 256 * u.pn + (tid - 256); }
    __device__ __forceinline__ const float* side_ptr1(const Unit& u, int tid) const {
        int lr = (u.pm - pst[u.e]) * BM + (tid & 255); if (lr >= cnt[u.e]) lr = 0; return lscale + (size_t)u.e * LIST_CAP + lr; }
    unsigned char* act; const float* bgu;
    const float* wsc; const float* lscale; const LAS int* pst; const LAS int* cnt;
    template <class AV> __device__ __forceinline__ void operator()(const AV (&acc)[2][2][4][2], const Unit& u, int wr, int wc, int fr, int fq, const LAS float* sd) const {
        const int row0 = u.pm * BM + wr * 64 + fr, ct = wc * 32 + 8 * fq;
        f32x4 bgv[2], blv[2], sgv[2], slv[2];
#pragma unroll
        for (int n = 0; n < 2; ++n) { bgv[n] = *(const LAS f32x4*)(sd + ct + 4 * n); blv[n] = *(const LAS f32x4*)(sd + 128 + ct + 4 * n); sgv[n] = *(const LAS f32x4*)(sd + 256 + ct + 4 * n); slv[n] = *(const LAS f32x4*)(sd + 384 + ct + 4 * n); }
#pragma unroll
        for (int ai = 0; ai < 2; ++ai)
#pragma unroll
            for (int mp = 0; mp < 2; ++mp) { u32x2 w2[2];
#pragma unroll
              for (int mm = 0; mm < 2; ++mm) { const int m = 2 * mp + mm; f32x2 o[4]; const float rs = sd[512 + wr * 64 + fr + ai * HALF + m * 16];
#pragma unroll
                for (int n = 0; n < 2; ++n) { const f32x4 sg = sgv[n] * rs, sl = slv[n] * rs; const f32x4 ag = tof(acc[ai][0][m][n]), al = tof(acc[ai][1][m][n]);
#pragma unroll
                    for (int h2 = 0; h2 < 2; ++h2) {
                        const f32x2 g = (f32x2){ag[2 * h2], ag[2 * h2 + 1]} * (f32x2){sg[2 * h2], sg[2 * h2 + 1]} + (f32x2){bgv[n][2 * h2], bgv[n][2 * h2 + 1]};
                        const f32x2 l = (f32x2){al[2 * h2], al[2 * h2 + 1]} * (f32x2){sl[2 * h2], sl[2 * h2 + 1]} + (f32x2){blv[n][2 * h2], blv[n][2 * h2 + 1]};
                        f32x2 glu, lin; glu.x = fminf(g.x, 7.0f); glu.y = fminf(g.y, 7.0f); lin.x = __builtin_amdgcn_fmed3f(l.x, -7.0f, 7.0f); lin.y = __builtin_amdgcn_fmed3f(l.y, -7.0f, 7.0f);
                        const f32x2 ea = glu * (-1.702f * LOG2E); f32x2 d; d.x = __builtin_amdgcn_exp2f(ea.x); d.y = __builtin_amdgcn_exp2f(ea.y); d = d + 1.0f;
                        f32x2 r; r.x = __builtin_amdgcn_rcpf(d.x); r.y = __builtin_amdgcn_rcpf(d.y);
                        o[2 * n + h2] = (glu * r) * (lin * 4.0f + 4.0f); } }
                u32x2 w; w.x = __builtin_amdgcn_cvt_pk_fp8_f32(o[0].x, o[0].y, 0, false); w.x = __builtin_amdgcn_cvt_pk_fp8_f32(o[1].x, o[1].y, w.x, true);
                w.y = __builtin_amdgcn_cvt_pk_fp8_f32(o[2].x, o[2].y, 0, false); w.y = __builtin_amdgcn_cvt_pk_fp8_f32(o[3].x, o[3].y, w.y, true);
                w2[mm] = w; }
              *(u32x4*)(act + (size_t)u.pm * 262144 + (size_t)(4 * u.pn + wc) * 8192 + (wr * 64 + fr + ai * HALF + (2 * mp + (fq & 1)) * 16) * 32 + 8 * (fq & 2)) = pair_rows16(w2[0], w2[1]); }
    }
};
struct EpiDown {
    static constexpr int PERM = 2; static constexpr bool SIDE = true;
    __device__ __forceinline__ const float* side_ptr0(const Unit& u, int tid) const { return (tid < 256 ? bd : wsc) + (size_t)u.e * 1024 + u.pn * BM + (tid & 255); }
    __device__ __forceinline__ const float* side_ptr1(const Unit& u, int tid) const { return bd; }
    unsigned char* out; const float* bd; const float* wsc;
    template <class AV> __device__ __forceinline__ void operator()(const AV (&acc)[2][2][4][2], const Unit& u, int wr, int wc, int fr, int fq, const LAS float* sd) const {
        const int row0 = u.pm * BM + wr * 64 + fr, cl = wc * 64 + fq * 16, ct = u.pn * BM + cl;
        f32x4 bv[2][2], sv[2][2];
#pragma unroll
        for (int bj = 0; bj < 2; ++bj)
#pragma unroll
            for (int n = 0; n < 2; ++n) { bv[bj][n] = *(const LAS f32x4*)(sd + cl + 8 * bj + 4 * n) * 4.0f; sv[bj][n] = *(const LAS f32x4*)(sd + 256 + cl + 8 * bj + 4 * n); }
#pragma unroll
        for (int ai = 0; ai < 2; ++ai)
#pragma unroll
            for (int m = 0; m < 4; ++m) { unsigned char* rowp = out + (size_t)(row0 + ai * HALF + m * 16) * DM + ct; u32x4 w;
#pragma unroll
                for (int bj = 0; bj < 2; ++bj) { f32x4 v0 = acc[ai][bj][m][0] * sv[bj][0] + bv[bj][0], v1 = acc[ai][bj][m][1] * sv[bj][1] + bv[bj][1];
#pragma unroll
                    for (int j = 0; j < 4; ++j) { v0[j] = __builtin_amdgcn_fmed3f(v0[j], -448.0f, 448.0f); v1[j] = __builtin_amdgcn_fmed3f(v1[j], -448.0f, 448.0f); }
                    unsigned a = __builtin_amdgcn_cvt_pk_fp8_f32(v0[0], v0[1], 0, false); a = __builtin_amdgcn_cvt_pk_fp8_f32(v0[2], v0[3], a, true);
                    unsigned b = __builtin_amdgcn_cvt_pk_fp8_f32(v1[0], v1[1], 0, false); b = __builtin_amdgcn_cvt_pk_fp8_f32(v1[2], v1[3], b, true);
                    if (bj == 0) { w.x = a; w.y = b; } else { w.z = a; w.w = b; } }
                *(u32x4*)rowp = w; }
    }
};
template <bool SECOND> struct EpiGate {
    static constexpr int PERM = 2; static constexpr bool SIDE = true;
    __device__ __forceinline__ const float* side_ptr0(const Unit& u, int tid) const { return wsc + u.pn * BM + (tid & 255); }
    __device__ __forceinline__ const float* side_ptr1(const Unit& u, int tid) const { return wsc; }
    unsigned char* merged; const unsigned char* mg; const float* wsc;
    template <class AV> __device__ __forceinline__ void operator()(const AV (&acc)[2][2][4][2], const Unit& u, int wr, int wc, int fr, int fq, const LAS float* sd) const {
        const int row0 = u.pm * BM + wr * 64 + fr, cl = wc * 64 + fq * 16, ct = u.pn * BM + cl;
        f32x4 sv[2][2];
#pragma unroll
        for (int bj = 0; bj < 2; ++bj)
#pragma unroll
            for (int n = 0; n < 2; ++n) sv[bj][n] = *(const LAS f32x4*)(sd + cl + 8 * bj + 4 * n) * (1.0f / 255.0f);
#pragma unroll
        for (int ai = 0; ai < 2; ++ai) {
            u32x4 z[4], p[4];
#pragma unroll
            for (int m = 0; m < 4; ++m) { const size_t row = (size_t)(row0 + ai * HALF + m * 16);
                z[m] = __builtin_nontemporal_load((const u32x4*)(mg + row * 2048 + (SECOND ? 1024 : 0) + ct));
                if (SECOND) p[m] = *(const u32x4*)(merged + row * DM + ct); }
            asm volatile("" ::: "memory");
#pragma unroll
            for (int m = 0; m < 4; ++m) { const size_t row = (size_t)(row0 + ai * HALF + m * 16); u32x4 w;
#pragma unroll
                for (int bj = 0; bj < 2; ++bj) { const unsigned zx = bj ? z[m].z : z[m].x, zy = bj ? z[m].w : z[m].y; float o[8]; const f32x4 a0 = acc[ai][bj][m][0] * sv[bj][0], a1 = acc[ai][bj][m][1] * sv[bj][1];
                    o[0] = (float)(zx & 255u) * a0[0]; o[1] = (float)((zx >> 8) & 255u) * a0[1]; o[2] = (float)((zx >> 16) & 255u) * a0[2]; o[3] = (float)(zx >> 24) * a0[3];
                    o[4] = (float)(zy & 255u) * a1[0]; o[5] = (float)((zy >> 8) & 255u) * a1[1]; o[6] = (float)((zy >> 16) & 255u) * a1[2]; o[7] = (float)(zy >> 24) * a1[3];
                    if (SECOND) { const unsigned px = bj ? p[m].z : p[m].x, py = bj ? p[m].w : p[m].y;
                        const f32x2 q0 = __builtin_amdgcn_cvt_pk_f32_fp8(px, false), q1 = __builtin_amdgcn_cvt_pk_f32_fp8(px, true), q2 = __builtin_amdgcn_cvt_pk_f32_fp8(py, false), q3 = __builtin_amdgcn_cvt_pk_f32_fp8(py, true);
                        o[0] += q0.x; o[1] += q0.y; o[2] += q1.x; o[3] += q1.y; o[4] += q2.x; o[5] += q2.y; o[6] += q3.x; o[7] += q3.y; }
                    unsigned a = __builtin_amdgcn_cvt_pk_fp8_f32(o[0], o[1], 0, false); a = __builtin_amdgcn_cvt_pk_fp8_f32(o[2], o[3], a, true);
                    unsigned b = __builtin_amdgcn_cvt_pk_fp8_f32(o[4], o[5], 0, false); b = __builtin_amdgcn_cvt_pk_fp8_f32(o[6], o[7], b, true);
                    if (bj == 0) { w.x = a; w.y = b; } else { w.z = a; w.w = b; } }
                *(u32x4*)(merged + row * DM + ct) = w; }
            asm volatile("" ::: "memory");
        }
    }
};
struct EpiMix {
    static constexpr bool PERM = true, SIDE = true;
    __device__ __forceinline__ const float* side_ptr0(const Unit& u, int tid) const { return wsc + u.pn * BM + (tid & 255); }
    __device__ __forceinline__ const float* side_ptr1(const Unit& u, int tid) const { return wsc; }
    bf16_t* out; const float* wsc;
    template <class AV> __device__ __forceinline__ void operator()(const AV (&acc)[2][2][4][2], const Unit& u, int wr, int wc, int fr, int fq, const LAS float* sd) const {
        const int row0 = u.pm * BM + wr * 64 + fr, ct = u.pn * BM + wc * 32 + 8 * fq;
        f32x4 sv[2][2];
#pragma unroll
        for (int bj = 0; bj < 2; ++bj)
#pragma unroll
            for (int n = 0; n < 2; ++n) sv[bj][n] = *(const LAS f32x4*)(sd + bj * HALF + wc * 32 + 8 * fq + 4 * n) * (1.0f / 16.0f);
#pragma unroll
        for (int ai = 0; ai < 2; ++ai)
#pragma unroll
            for (int m = 0; m < 4; ++m) { bf16_t* rowp = out + (size_t)(row0 + ai * HALF + m * 16) * DM + ct;
#pragma unroll
                for (int bj = 0; bj < 2; ++bj) { const f32x4 v0 = acc[ai][bj][m][0] * sv[bj][0], v1 = acc[ai][bj][m][1] * sv[bj][1];
                    u32x4 w; w.x = pk2(v0[0], v0[1]); w.y = pk2(v0[2], v0[3]); w.z = pk2(v1[0], v1[1]); w.w = pk2(v1[2], v1[3]);
                    *(u32x4*)(rowp + bj * HALF) = w; } }
    }
};
}

struct Frame {
    LAS unsigned char* lds;
    unsigned char* ws; unsigned* ctl;
    int tid, lane, wave, G, bid;
    const float* in[24]; float* out;
};

__device__ __forceinline__ void tr_item(const float* W, size_t ldw, int k0, size_t nsrc0, int nvalid, bf16_t* dst, size_t ldt, LAS float* scr, int lane) {
#pragma unroll 8
    for (int i = 0; i < 32; ++i) { const int kk = 2 * i + (lane >> 5), j = lane & 31; float v = 0.f; if (j < nvalid) v = W[(size_t)(k0 + kk) * ldw + nsrc0 + j]; scr[kk * 33 + j] = v; }
    LDS_WAIT(); asm volatile("" ::: "memory");
    const int c = lane & 7;
#pragma unroll
    for (int j = 0; j < 4; ++j) { const int n = (lane >> 3) + 8 * j; const LAS float* s = scr + (8 * c) * 33 + n;
        u32x4 o; o.x = pk2(s[0 * 33], s[1 * 33]); o.y = pk2(s[2 * 33], s[3 * 33]); o.z = pk2(s[4 * 33], s[5 * 33]); o.w = pk2(s[6 * 33], s[7 * 33]);
        *(u32x4*)(dst + (size_t)n * ldt + 8 * c) = o; }
    LDS_WAIT(); asm volatile("" ::: "memory");
}
template <bool FP8, int KROWS = 1024>
__device__ __forceinline__ void quant_block_item(const float* W, size_t ldw, size_t nsrc, int nvalid, signed char* dst, float* scale_out, LAS unsigned char* lds, int tid) {
    LAS unsigned char* slab = lds;
    LAS float* pmax = (LAS float*)(lds + 132352);
    LAS float* cinv = (LAS float*)(lds + 132352 + 2048);
    LAS unsigned* tt = (LAS unsigned*)(lds + 134656);
    const int c4 = tid & 15, r4 = tid >> 4;
    const bool cv = 4 * c4 < nvalid;
    const float* wp = W + nsrc + 4 * c4;
    f32x4 am = {0.f, 0.f, 0.f, 0.f};
#pragma unroll 8
    for (int st = 0; st < KROWS / 32; ++st) { f32x4 v = {0.f, 0.f, 0.f, 0.f}; if (cv) v = __builtin_nontemporal_load((const f32x4*)(wp + (size_t)(32 * st + r4) * ldw));
        am[0] = fmaxf(am[0], fabsf(v[0])); am[1] = fmaxf(am[1], fabsf(v[1])); am[2] = fmaxf(am[2], fabsf(v[2])); am[3] = fmaxf(am[3], fabsf(v[3]));
        u32x2 pw; pw.x = pk2(v[0], v[1]); pw.y = pk2(v[2], v[3]); *(LAS u32x2*)(slab + (32 * st + r4) * 128 + c4 * 8) = pw; }
#pragma unroll
    for (int k = 0; k < 4; ++k) { am[k] = fmaxf(am[k], __shfl_xor(am[k], 16)); am[k] = fmaxf(am[k], __shfl_xor(am[k], 32)); }
    if ((tid & 63) < 16) *(LAS f32x4*)(pmax + (tid >> 6) * 64 + 4 * c4) = am;
    __syncthreads();
    if (tid < 64) { float a = 0.f;
#pragma unroll
        for (int w = 0; w < 8; ++w) a = fmaxf(a, pmax[w * 64 + tid]);
        if (FP8) { const int ex = (int)((__float_as_uint(a) >> 23) & 255u) - 127 - 7;
            cinv[tid] = a > 0.f ? __uint_as_float((unsigned)(127 - ex) << 23) : 0.f; scale_out[tid] = a > 0.f ? __uint_as_float((unsigned)(127 + ex) << 23) : 1.0f; }
        else { cinv[tid] = a > 0.f ? 127.0f / a : 0.f; scale_out[tid] = a > 0.f ? a * (1.0f / 127.0f) : 1.0f; } }
    __syncthreads();
    const f32x4 iv = *(const LAS f32x4*)(cinv + 4 * c4);
    for (int qd = 0; qd < KROWS / 256; ++qd) {
#pragma unroll
        for (int s2 = 0; s2 < 2; ++s2) {
            f32x4 v[4];
#pragma unroll
            for (int i = 0; i < 4; ++i) { const u32x2 pw = *(const LAS u32x2*)(slab + (256 * qd + 128 * s2 + 4 * r4 + i) * 128 + c4 * 8); v[i] = (f32x4){bflo(pw.x), bfhi(pw.x), bflo(pw.y), bfhi(pw.y)}; }
#pragma unroll
            for (int c = 0; c < 4; ++c) { unsigned wq;
                if (FP8) { wq = __builtin_amdgcn_cvt_pk_fp8_f32(v[0][c] * iv[c], v[1][c] * iv[c], 0, false); wq = __builtin_amdgcn_cvt_pk_fp8_f32(v[2][c] * iv[c], v[3][c] * iv[c], wq, true); }
                else wq = pk4(rintf(v[0][c] * iv[c]), rintf(v[1][c] * iv[c]), rintf(v[2][c] * iv[c]), rintf(v[3][c] * iv[c]));
                tt[(4 * c4 + c) * 65 + 32 * s2 + r4] = wq; }
        }
        __syncthreads();
#pragma unroll
        for (int it = 0; it < 8; ++it) { const int n = 8 * it + (tid >> 6), kd = tid & 63; *(unsigned*)(dst + (size_t)n * 1024 + 256 * qd + 4 * kd) = tt[n * 65 + kd]; }
        __syncthreads();
    }
}
constexpr int N_EXPERT_ITEMS = 1024 + 512;
__device__ __forceinline__ void expert_quant_item(Frame& F, int it) {
    unsigned char* ws = F.ws;
    if (it < 1024) { const int e = it >> 5, n0 = 64 * (it & 31), pn = n0 >> 8, j = n0 & 255; const int nsrc = j < 128 ? 128 * pn + j : 1024 + 128 * pn + (j - 128);
        quant_block_item<false>(F.in[18] + (size_t)e * 1024 * 2048, 2048, nsrc, 64, (signed char*)(ws + WS_WGU) + ((size_t)e * 2048 + n0) * 1024, (float*)(ws + WS_WSGU) + e * 2048 + n0, F.lds, F.tid); }
    else { const int r2 = it - 1024, e = r2 >> 4, n0 = 64 * (r2 & 15);
        quant_block_item<true>(F.in[20] + (size_t)e * 1024 * 1024, 1024, n0, 64, (signed char*)(ws + WS_WDN) + ((size_t)e * 1024 + n0) * 1024, (float*)(ws + WS_WSDN) + e * 1024 + n0, F.lds, F.tid); }
}
__device__ __forceinline__ void p0_prologue(Frame& F) {
    LAS float* scr = (LAS float*)(F.lds + F.wave * 16384);
    const int gw = F.bid * NWAVES + F.wave, NGW = F.G * NWAVES, lane = F.lane;
    unsigned char* ws = F.ws;
    constexpr int I_C1 = 32 * 4, I_C2 = 2 * 2;
    constexpr int NITEMS = 2 * I_C1 + 2 * I_C2;
    for (int it = F.bid; it < 68 + 48; it += F.G) {
        if (it >= 68) { const int r3 = it - 68, which = r3 >> 4, n0 = 64 * (r3 & 15);
            if (which == 0) quant_block_item<true, 512>(F.in[11], 1024, n0, 64, (signed char*)(ws + WS_WAB) + (size_t)n0 * 1024, (float*)(ws + WS_WSAB) + n0, F.lds, F.tid);
            else if (which == 1) quant_block_item<true, 512>(F.in[12], 1024, n0, 64, (signed char*)(ws + WS_WAB) + (size_t)n0 * 1024 + 512, (float*)(ws + WS_WSAB) + 1024 + n0, F.lds, F.tid);
            else quant_block_item<true, 1024>(F.in[13], 1024, n0, 64, (signed char*)(ws + WS_WOUT) + (size_t)n0 * 1024, (float*)(ws + WS_WSAB) + 2048 + n0, F.lds, F.tid); }
        else { const int n0 = 64 * it; size_t nsrc; int nv = 64;
            if (n0 < 2048) nsrc = n0; else if (n0 < 4096) nsrc = n0 + 24; else if (n0 == 4096) { nsrc = 2048; nv = 24; } else { nsrc = 0; nv = 0; }
            quant_block_item<false>(F.in[1], 4120, nsrc, nv, (signed char*)(ws + WS_WIN) + (size_t)n0 * 1024, (float*)(ws + WS_WSIN) + n0, F.lds, F.tid); }
    }
    for (int it = F.bid; it < 256; it += F.G) { const int kv = it >> 7, n = it & 127; const float* pos = kv ? F.in[8] : F.in[5]; const float* w1 = kv ? F.in[9] : F.in[6];
        float sacc = 0.f;
#pragma unroll
        for (int k = F.tid; k < 2048; k += 512) sacc += pos[k] * w1[(size_t)k * 128 + n];
        sacc = wave_sum(sacc); LAS float* red = (LAS float*)F.lds;
        __syncthreads(); if (lane == 0) red[F.wave] = sacc; __syncthreads();
        if (F.tid == 0) ((float*)(ws + WS_B1))[it] = ((red[0] + red[1]) + (red[2] + red[3])) + ((red[4] + red[5]) + (red[6] + red[7])); }
    __syncthreads();
    for (int it = gw; it < NITEMS; it += NGW) {
        int r = it;
        if (r < 2 * I_C1) { const int kv = r / I_C1, q = r % I_C1, kb = q / 4, nb = q % 4;
            tr_item(kv ? F.in[9] : F.in[6], 128, 64 * kb, 32 * nb, 32, (bf16_t*)(ws + WS_CW1) + ((size_t)kv * 128 + 32 * nb) * 2048 + 64 * kb, 2048, scr, lane); continue; }
        r -= 2 * I_C1;
        { const int kv = r / I_C2, q = r % I_C2, kb = q / 2, nb = q % 2;
            tr_item(kv ? F.in[10] : F.in[7], 64, 64 * kb, 32 * nb, 32, (bf16_t*)(ws + WS_CW2) + ((size_t)kv * 64 + 32 * nb) * 128 + 64 * kb, 128, scr, lane); }
    }
    for (int m = gw; m < T; m += NGW) {
        const f32x4* xr = (const f32x4*)(F.in[0] + (size_t)m * DM) + lane; unsigned* o = (unsigned*)(ws + WS_XB + (size_t)m * DM) + lane;
        f32x4 v[4]; float amax = 0.f;
#pragma unroll
        for (int j = 0; j < 4; ++j) { v[j] = xr[64 * j]; amax = fmaxf(fmaxf(amax, fmaxf(fabsf(v[j][0]), fabsf(v[j][1]))), fmaxf(fabsf(v[j][2]), fabsf(v[j][3]))); }
        amax = wave_max_nonneg(amax);
        const float inv = amax > 0.f ? 127.0f / amax : 0.f;
        if (lane == 0) ((float*)(ws + WS_XS))[m] = amax > 0.f ? amax * (1.0f / 127.0f) : 1.0f;
#pragma unroll
        for (int j = 0; j < 4; ++j) o[64 * j] = pk4(rintf(v[j][0] * inv), rintf(v[j][1] * inv), rintf(v[j][2] * inv), rintf(v[j][3] * inv));
    }
    for (int n = F.bid * 512 + F.tid; n < NPROJ; n += F.G * 512) {
        float v = 0.f; if (n < 2048) v = F.in[2][n]; else if (n < 4096) v = F.in[2][n + 24]; else if (n < 4120) v = F.in[2][n - 4096 + 2048];
        ((float*)(ws + WS_BINP))[n] = v; }
}

__device__ __forceinline__ int crow(int r, int hi) { return (r & 3) + 8 * (r >> 2) + 4 * hi; }
__device__ __forceinline__ float half_other_max(float v) { auto rr = __builtin_amdgcn_permlane32_swap(__float_as_uint(v), __float_as_uint(v), false, false); return fmaxf(__uint_as_float(rr[0]), __uint_as_float(rr[1])); }
__device__ __forceinline__ float half_other_sum(float v) { auto rr = __builtin_amdgcn_permlane32_swap(__float_as_uint(v), __float_as_uint(v), false, false); return __uint_as_float(rr[0]) + __uint_as_float(rr[1]); }

constexpr int AL_K = 0, AL_V = 16384, AL_TAB = 32768  , AL_SEL = 40960  , AL_IMP = 41216  ,
              AL_IMPS = 75008  , AL_OST = 83456  , AL_END = 116224;
static_assert(AL_END <= LDSCTL_OFF, "attention lds");

__device__ __forceinline__ void tile_load(const bf16_t* kbase, const bf16_t* vbase, size_t pitch, int tid, u32x4& kr, u32x4& vr) {
    const int r = tid >> 3, c = tid & 7;
    kr = *(const u32x4*)(kbase + (size_t)r * pitch + c * 8); vr = *(const u32x4*)(vbase + (size_t)r * pitch + c * 8);
}
__device__ __forceinline__ void tile_store(LAS unsigned char* kbuf, LAS unsigned char* vbuf, int tid, const u32x4& kr, const u32x4& vr) {
    const int r = tid >> 3, c = tid & 7;
    *(LAS u32x4*)(kbuf + r * 128 + ((c ^ ((r >> 1) & 7)) << 4)) = kr;
    *(LAS u32x4*)(vbuf + r * 128 + ((c ^ (((r >> 1) & 1) << 2)) << 4)) = vr;
}
__device__ __forceinline__ void qk_tile(const LAS unsigned char* kbuf, const bf16x8 (&qf)[4], int r32, int hi, f32x16& p0, f32x16& p1) {
    const f32x16 z = {0.f, 0.f, 0.f, 0.f, 0.f, 0.f, 0.f, 0.f, 0.f, 0.f, 0.f, 0.f, 0.f, 0.f, 0.f, 0.f};
    p0 = z; p1 = z;
    const int sw0 = (r32 >> 1) & 7;
#pragma unroll
    for (int d0 = 0; d0 < 4; ++d0) {
        const int ch = ((2 * d0 + hi) ^ sw0) << 4;
        const bf16x8 a0 = *(const LAS bf16x8*)(kbuf + r32 * 128 + ch);
        const bf16x8 a1 = *(const LAS bf16x8*)(kbuf + (32 + r32) * 128 + ch);
        p0 = __builtin_amdgcn_mfma_f32_32x32x16_bf16(a0, qf[d0], p0, 0, 0, 0);
        p1 = __builtin_amdgcn_mfma_f32_32x32x16_bf16(a1, qf[d0], p1, 0, 0, 0);
    }
}
__device__ __forceinline__ s16x4 vtr(const LAS unsigned char* p) { typedef short v4i16_t __attribute__((ext_vector_type(4))); return __builtin_bit_cast(s16x4, __builtin_amdgcn_ds_read_tr16_b64_v4i16((LAS v4i16_t*)p)); }
__device__ __forceinline__ bf16x8 pack8(const f32x16& p, int s) {
    u32x4 w; w.x = pk2(p[8 * s + 0], p[8 * s + 1]); w.y = pk2(p[8 * s + 2], p[8 * s + 3]); w.z = pk2(p[8 * s + 4], p[8 * s + 5]); w.w = pk2(p[8 * s + 6], p[8 * s + 7]);
    return __builtin_bit_cast(bf16x8, w);
}
__device__ __forceinline__ void pv_tile(const LAS unsigned char* vbuf, const f32x16& p0, const f32x16& p1, f32x16& o0, f32x16& o1, int lane) {
    const int hi = lane >> 5, dsub = (lane >> 4) & 1, q = (lane & 15) >> 2, p = lane & 3;
    const int swz = ((q >> 1) & 1) << 2;
    const LAS unsigned char* vb = vbuf + (4 * hi + q) * 128 + 8 * (p & 1);
    const int c0 = ((2 * dsub + (p >> 1)) ^ swz) << 4, c1 = ((4 + 2 * dsub + (p >> 1)) ^ swz) << 4;
#pragma unroll
    for (int blk = 0; blk < 2; ++blk)
#pragma unroll
        for (int s = 0; s < 2; ++s) {
            const bf16x8 pf = pack8(blk ? p1 : p0, s);
            const int rowoff = (32 * blk + 16 * s) * 128;
            const s16x4 lo0 = vtr(vb + rowoff + c0), hi0 = vtr(vb + rowoff + 8 * 128 + c0);
            const s16x4 lo1 = vtr(vb + rowoff + c1), hi1 = vtr(vb + rowoff + 8 * 128 + c1);
            const bf16x8 v0 = __builtin_shufflevector(lo0, hi0, 0, 1, 2, 3, 4, 5, 6, 7), v1 = __builtin_shufflevector(lo1, hi1, 0, 1, 2, 3, 4, 5, 6, 7);
            o0 = __builtin_amdgcn_mfma_f32_32x32x16_bf16(v0, pf, o0, 0, 0, 0);
            o1 = __builtin_amdgcn_mfma_f32_32x32x16_bf16(v1, pf, o1, 0, 0, 0);
        }
}
template <bool SIMPLE>
__device__ __forceinline__ void softmax_tile(f32x16& p0, f32x16& p1, int base_rel, unsigned win, bool lane_on, const LAS float* tab, float bfar,
                                             float& m, float& l, f32x16& o0, f32x16& o1) {
    const float NEG = -INFINITY;
    if (SIMPLE) {
        const float lb = lane_on ? bfar : NEG;
#pragma unroll
        for (int r = 0; r < 16; ++r) { p0[r] = __builtin_fmaf(p0[r], C2, lb); p1[r] = __builtin_fmaf(p1[r], C2, lb); }
    } else {
#pragma unroll
        for (int blk = 0; blk < 2; ++blk)
#pragma unroll
            for (int r = 0; r < 16; ++r) {
                const float pv = blk ? p1[r] : p0[r];
                const int rel = base_rel - (32 * blk + (r & 3) + 8 * (r >> 2));
                const float bias = tab[min((unsigned)rel, 127u)];
                const bool ok = ((unsigned)rel < win) && lane_on;
                const float sv = ok ? __builtin_fmaf(pv, C2, bias) : NEG;
                if (blk) p1[r] = sv; else p0[r] = sv;
            }
    }
    float m0 = fmaxf(p0[0], p1[0]), m1 = fmaxf(p0[1], p1[1]), m2 = fmaxf(p0[2], p1[2]), m3 = fmaxf(p0[3], p1[3]);
#pragma unroll
    for (int r = 4; r < 16; r += 4) { m0 = fmaxf(m0, fmaxf(p0[r], p1[r])); m1 = fmaxf(m1, fmaxf(p0[r + 1], p1[r + 1])); m2 = fmaxf(m2, fmaxf(p0[r + 2], p1[r + 2])); m3 = fmaxf(m3, fmaxf(p0[r + 3], p1[r + 3])); }
    const float mx = half_other_max(fmaxf(fmaxf(m0, m1), fmaxf(m2, m3)));
    const float mn = fmaxf(m, mx), alpha = __builtin_amdgcn_exp2f(m - mn);
    m = mn;
    float s0 = 0.f, s1 = 0.f, s2 = 0.f, s3 = 0.f;
#pragma unroll
    for (int r = 0; r < 16; r += 2) { p0[r] = __builtin_amdgcn_exp2f(p0[r] - mn); p0[r + 1] = __builtin_amdgcn_exp2f(p0[r + 1] - mn); p1[r] = __builtin_amdgcn_exp2f(p1[r] - mn); p1[r + 1] = __builtin_amdgcn_exp2f(p1[r + 1] - mn);
        s0 += p0[r]; s1 += p0[r + 1]; s2 += p1[r]; s3 += p1[r + 1]; }
    l = l * alpha + ((s0 + s1) + (s2 + s3));
#pragma unroll
    for (int r = 0; r < 16; ++r) { o0[r] *= alpha; o1[r] *= alpha; }
}
__device__ __forceinline__ void build_bias_tab(Frame& F) {
    LAS float* tab = (LAS float*)(F.lds + AL_TAB);
    for (int i = F.tid; i < 16 * 128; i += 512) { const int h = i >> 7, rel = i & 127; int bk;
        if (rel < 16) bk = rel; else { bk = 16 + (rel >= 19) + (rel >= 21) + (rel >= 24) + (rel >= 27) + (rel >= 31) + (rel >= 35) + (rel >= 40) + (rel >= 46)
                + (rel >= 52) + (rel >= 59) + (rel >= 67) + (rel >= 77) + (rel >= 87) + (rel >= 99) + (rel >= 113); }
        tab[i] = F.in[3][bk * 16 + h] * LOG2E; }
}
__device__ __forceinline__ void branch_fold(const f32x16& o0, const f32x16& o1, float l, float gate, f32x16& oc0, f32x16& oc1) {
    const float lt = half_other_sum(l); const float sc = lt > 0.f ? gate / lt : 0.f;
#pragma unroll
    for (int r = 0; r < 16; ++r) { oc0[r] += o0[r] * sc; oc1[r] += o1[r] * sc; }
}
__device__ __forceinline__ void store_o8(LAS unsigned char* ost, const f32x16& oc0, const f32x16& oc1, unsigned char* dst  , int lane) {
    const int q = lane & 31, hi = lane >> 5;
#pragma unroll
    for (int dblk = 0; dblk < 2; ++dblk)
#pragma unroll
        for (int g4 = 0; g4 < 4; ++g4) { const f32x16& o = dblk ? oc1 : oc0; unsigned w = __builtin_amdgcn_cvt_pk_fp8_f32(16.0f * o[4 * g4 + 0], 16.0f * o[4 * g4 + 1], 0, false);
            w = __builtin_amdgcn_cvt_pk_fp8_f32(16.0f * o[4 * g4 + 2], 16.0f * o[4 * g4 + 3], w, true);
            *(LAS unsigned*)(ost + q * 64 + 32 * dblk + 8 * g4 + 4 * hi) = w; }
    LDS_WAIT(); asm volatile("" ::: "memory");
#pragma unroll
    for (int it = 0; it < 2; ++it) { const int row = it * 16 + (lane >> 2), ch = lane & 3; const u32x4 v = *(const LAS u32x4*)(ost + row * 64 + ch * 16);
        *(u32x4*)(dst + (size_t)row * 1024 + ch * 16) = v; }
    LDS_WAIT(); asm volatile("" ::: "memory");
}
__device__ __forceinline__ void store_o(LAS unsigned char* ost, const f32x16& oc0, const f32x16& oc1, bf16_t* dst  , int lane) {
    const int q = lane & 31, hi = lane >> 5;
#pragma unroll
    for (int dblk = 0; dblk < 2; ++dblk)
#pragma unroll
        for (int g4 = 0; g4 < 4; ++g4) { const f32x16& o = dblk ? oc1 : oc0; u32x2 w; w.x = pk2(o[4 * g4 + 0], o[4 * g4 + 1]); w.y = pk2(o[4 * g4 + 2], o[4 * g4 + 3]);
            *(LAS u32x2*)(ost + q * 128 + (32 * dblk + 8 * g4 + 4 * hi) * 2) = w; }
    LDS_WAIT(); asm volatile("" ::: "memory");
#pragma unroll
    for (int it = 0; it < 4; ++it) { const int row = it * 8 + (lane >> 3), ch = lane & 7; const u32x4 v = *(const LAS u32x4*)(ost + row * 128 + ch * 16);
        *(u32x4*)(dst + (size_t)row * 1024 + ch * 8) = v; }
    LDS_WAIT(); asm volatile("" ::: "memory");
}
__device__ __forceinline__ void attn_unit_decode(int U, int& b, int& g, int& i) {
    const int rr = U >> 8, p = (U & 255) >> 2, s = U & 3; b = p >> 1; g = p & 1; i = (rr & 1) ? 4 * rr + 3 - s : 4 * rr + s;
}

__device__ __forceinline__ void attnA_unit(Frame& F, int U) {
    int b, g, i; attn_unit_decode(U, b, g, i);
    const int tid = F.tid, lane = F.lane, w = F.wave, q = lane & 31, hi = lane >> 5, hq = w >> 1;
    const int t0 = 64 * i, tw0 = t0 + 32 * (w & 1), tq = tw0 + q; const size_t tokb = (size_t)b * SEQ;
    const bf16_t* QA = (const bf16_t*)(F.ws + WS_QA); const bf16_t* KVA = (const bf16_t*)(F.ws + WS_KVA);
    LAS unsigned char* lds = F.lds;
    bf16x8 qf[4];
#pragma unroll
    for (int d0 = 0; d0 < 4; ++d0) qf[d0] = *(const bf16x8*)(QA + (tokb + tq) * 512 + (g * 4 + hq) * 64 + 16 * d0 + 8 * hi);
    const LAS float* tab = (const LAS float*)(lds + AL_TAB) + (g * 4 + hq) * 128;
    const float bfar = tab[127];
    float m = F.in[4][g * 4 + hq] * LOG2E, l = hi == 0 ? 1.f : 0.f;
    f32x16 o0, o1; { const f32x16 z = {0.f, 0.f, 0.f, 0.f, 0.f, 0.f, 0.f, 0.f, 0.f, 0.f, 0.f, 0.f, 0.f, 0.f, 0.f, 0.f}; o0 = z; o1 = z; }
    const int j0 = i >= 2 ? i - 2 : 0, nt = i - j0 + 1;
    const bf16_t* kg = KVA + tokb * 256 + g * 64; const bf16_t* vg = kg + 128;
    u32x4 kr, vr;
    tile_load(kg + (size_t)(64 * j0) * 256, vg + (size_t)(64 * j0) * 256, 256, tid, kr, vr);
    tile_store(lds + AL_K, lds + AL_V, tid, kr, vr);
    __syncthreads();
    for (int n = 0; n < nt; ++n) {
        const int j = j0 + n, kb = 64 * j;
        if (n + 1 < nt) tile_load(kg + (size_t)(kb + 64) * 256, vg + (size_t)(kb + 64) * 256, 256, tid, kr, vr);
        const LAS unsigned char* kbuf = lds + AL_K + (n & 1) * 8192; const LAS unsigned char* vbuf = lds + AL_V + (n & 1) * 8192;
        const int minrel = tw0 - (kb + 63), maxrel = tw0 + 31 - kb;
        if (maxrel >= 0 && minrel < 128) {
            f32x16 p0, p1; qk_tile(kbuf, qf, q, hi, p0, p1);
            softmax_tile<false>(p0, p1, tq - kb - 4 * hi, 128u, true, tab, bfar, m, l, o0, o1);
            pv_tile(vbuf, p0, p1, o0, o1, lane);
        }
        if (n + 1 < nt) tile_store(lds + AL_K + ((n + 1) & 1) * 8192, lds + AL_V + ((n + 1) & 1) * 8192, tid, kr, vr);
        __syncthreads();
    }
    f32x16 oc0, oc1; { const f32x16 z = {0.f, 0.f, 0.f, 0.f, 0.f, 0.f, 0.f, 0.f, 0.f, 0.f, 0.f, 0.f, 0.f, 0.f, 0.f, 0.f}; oc0 = z; oc1 = z; }
    branch_fold(o0, o1, l, 1.0f, oc0, oc1);
    store_o8(lds + AL_OST + w * 4096, oc0, oc1, (unsigned char*)(F.ws + WS_Y) + (tokb + tw0) * 1024 + (g * 4 + hq) * 64, lane);
}

__device__ __forceinline__ void nsa_unit(Frame& F, int U) {
    int b, g, i; attn_unit_decode(U, b, g, i);
    const int tid = F.tid, lane = F.lane, w = F.wave, q = lane & 31, hi = lane >> 5, hq = w >> 1;
    const int t0 = 64 * i, tw0 = t0 + 32 * (w & 1), tq = tw0 + q; const size_t tokb = (size_t)b * SEQ;
    const bf16_t* QB = (const bf16_t*)(F.ws + WS_QB);
    const bf16_t* KVS = (const bf16_t*)(F.ws + WS_KVC + 32 * MiB); const bf16_t* KVW = (const bf16_t*)(F.ws + WS_KVC + 64 * MiB);
    const bf16_t* KC = (const bf16_t*)(F.ws + WS_KC) + (size_t)(b * 2 + g) * 128 * 64; const bf16_t* VC = (const bf16_t*)(F.ws + WS_VC) + (size_t)(b * 2 + g) * 128 * 64;
    LAS unsigned char* lds = F.lds;
    const f32x16 z16 = {0.f, 0.f, 0.f, 0.f, 0.f, 0.f, 0.f, 0.f, 0.f, 0.f, 0.f, 0.f, 0.f, 0.f, 0.f, 0.f};
    bf16x8 qf[4];
#pragma unroll
    for (int d0 = 0; d0 < 4; ++d0) qf[d0] = *(const bf16x8*)(QB + (tokb + tq) * 512 + (g * 4 + hq) * 64 + 16 * d0 + 8 * hi);
    const LAS float* tab = (const LAS float*)(lds + AL_TAB) + (8 + g * 4 + hq) * 128;
    const float bfar = tab[127];
    float gate[3];
    { const bf16_t* ngp = (const bf16_t*)(F.ws + WS_NG) + (tokb + tq) * 32 + (g * 4 + hq) * 3;
#pragma unroll
      for (int k = 0; k < 3; ++k) gate[k] = fsigmoid(__uint_as_float((unsigned)ngp[k] << 16)); }
    f32x16 oc0 = z16, oc1 = z16, o0, o1;
    u32x4 kr, vr;
    tile_load(KC, VC, 64, tid, kr, vr); tile_store(lds + AL_K, lds + AL_V, tid, kr, vr);
    tile_load(KC + 64 * 64, VC + 64 * 64, 64, tid, kr, vr); tile_store(lds + AL_K + 8192, lds + AL_V + 8192, tid, kr, vr);
    __syncthreads();
    {
        f32x16 pa, pb, pc, pd;
        qk_tile(lds + AL_K, qf, q, hi, pa, pb); qk_tile(lds + AL_K + 8192, qf, q, hi, pc, pd);
        const int nvalid = tq >= 31 ? ((tq - 31) >> 4) + 1 : 0;
        float mx = -INFINITY;
#pragma unroll
        for (int r = 0; r < 16; ++r) { const int c = crow(r, hi);
            pa[r] = (c < nvalid) ? pa[r] * C2 : -INFINITY; pb[r] = (32 + c < nvalid) ? pb[r] * C2 : -INFINITY;
            pc[r] = (64 + c < nvalid) ? pc[r] * C2 : -INFINITY; pd[r] = (96 + c < nvalid) ? pd[r] * C2 : -INFINITY;
            mx = fmaxf(fmaxf(mx, pa[r]), fmaxf(fmaxf(pb[r], pc[r]), pd[r])); }
        mx = half_other_max(mx); if (nvalid == 0) mx = 0.f;
        float sum = 0.f;
#pragma unroll
        for (int r = 0; r < 16; ++r) { pa[r] = __builtin_amdgcn_exp2f(pa[r] - mx); pb[r] = __builtin_amdgcn_exp2f(pb[r] - mx); pc[r] = __builtin_amdgcn_exp2f(pc[r] - mx); pd[r] = __builtin_amdgcn_exp2f(pd[r] - mx);
            sum += (pa[r] + pb[r]) + (pc[r] + pd[r]); }
        sum = half_other_sum(sum);
        const float inv = nvalid > 0 ? 1.0f / sum : 0.f;
#pragma unroll
        for (int r = 0; r < 16; ++r) { pa[r] *= inv; pb[r] *= inv; pc[r] *= inv; pd[r] *= inv; }
        o0 = z16; o1 = z16;
        pv_tile(lds + AL_V, pa, pb, o0, o1, lane); pv_tile(lds + AL_V + 8192, pc, pd, o0, o1, lane);
#pragma unroll
        for (int r = 0; r < 16; ++r) { oc0[r] += gate[0] * o0[r]; oc1[r] += gate[0] * o1[r]; }
        if (i >= 8) {
            LAS float* impw = (LAS float*)(lds + AL_IMP) + (hq * 64 + 32 * (w & 1) + q) * 33;
            float yprev = 0.f;
#pragma unroll
            for (int b4 = 0; b4 < 4; ++b4) { const f32x16& pp = b4 == 0 ? pa : b4 == 1 ? pb : b4 == 2 ? pc : pd;
#pragma unroll
                for (int g4 = 0; g4 < 4; ++g4) { const float a0 = pp[4 * g4], a1 = pp[4 * g4 + 1], a2 = pp[4 * g4 + 2], a3 = pp[4 * g4 + 3];
                    auto rr = __builtin_amdgcn_permlane32_swap(__float_as_uint(a3), __float_as_uint(a3), false, false);
                    const float ylo = __uint_as_float(rr[0]), yhi = __uint_as_float(rr[1]);
                    const float prev = hi ? ylo : yprev;
                    impw[8 * b4 + 2 * g4 + hi] = (a0 + a1) + (a2 + 0.5f * a3) + 0.5f * prev;
                    yprev = yhi; } }
        }
    }
    __syncthreads();
    if (i >= 8) {
        const int tok = tid >> 3, sub = tid & 7;
        { const LAS float* ip = (const LAS float*)(lds + AL_IMP) + tok * 33 + 4 * sub; LAS float* isum = (LAS float*)(lds + AL_IMPS) + tok * 33 + 4 * sub;
#pragma unroll
          for (int jj = 0; jj < 4; ++jj) { const int j = 4 * sub + jj; float v = (ip[jj] + ip[64 * 33 + jj]) + (ip[2 * 64 * 33 + jj] + ip[3 * 64 * 33 + jj]);
              if (j == 0 || (j <= i && j > i - 2)) v = 1e30f; if (j > i) v = -1e30f; isum[jj] = v; } }
        __syncthreads();
        { const LAS float* isum = (const LAS float*)(lds + AL_IMPS) + tok * 33; float mine[4]; int rank[4] = {0, 0, 0, 0};
#pragma unroll
          for (int jj = 0; jj < 4; ++jj) mine[jj] = isum[4 * sub + jj];
#pragma unroll 8
          for (int j2 = 0; j2 < 32; ++j2) { const float v2 = isum[j2];
#pragma unroll
              for (int jj = 0; jj < 4; ++jj) rank[jj] += (v2 > mine[jj] || (v2 == mine[jj] && j2 < 4 * sub + jj)) ? 1 : 0; }
          unsigned bits = 0;
#pragma unroll
          for (int jj = 0; jj < 4; ++jj) if (rank[jj] < 8 && (4 * sub + jj) <= i) bits |= 1u << (4 * sub + jj);
          bits |= __shfl_xor(bits, 1); bits |= __shfl_xor(bits, 2); bits |= __shfl_xor(bits, 4);
          if (sub == 0) ((LAS unsigned*)(lds + AL_SEL))[tok] = bits; }
    } else {
        if (tid < 64) ((LAS unsigned*)(lds + AL_SEL))[tid] = (2u << i) - 1u;
    }
    __syncthreads();
    const unsigned selw = ((const LAS unsigned*)(lds + AL_SEL))[32 * (w & 1) + q];
    const int nslc = i + 1, jw0 = i >= 8 ? i - 8 : 0, nwin = i - jw0 + 1, ntile = nslc + nwin;
    const bf16_t* ks = KVS + tokb * 256 + g * 64; const bf16_t* kw = KVW + tokb * 256 + g * 64;
    tile_load(ks, ks + 128, 256, tid, kr, vr); tile_store(lds + AL_K, lds + AL_V, tid, kr, vr);
    __syncthreads();
    float m = -1e30f, l = 0.f; o0 = z16; o1 = z16;
    for (int n = 0; n < ntile; ++n) {
        if (n + 1 < ntile) { const int n1 = n + 1; const bf16_t* src = n1 < nslc ? ks + (size_t)(64 * n1) * 256 : kw + (size_t)(64 * (jw0 + n1 - nslc)) * 256;
            tile_load(src, src + 128, 256, tid, kr, vr); }
        if (n == nslc) { branch_fold(o0, o1, l, gate[1], oc0, oc1); m = -1e30f; l = 0.f; o0 = z16; o1 = z16; }
        const bool is_slc = n < nslc; const int j = is_slc ? n : jw0 + n - nslc, kb = 64 * j;
        const LAS unsigned char* kbuf = lds + AL_K + (n & 1) * 8192; const LAS unsigned char* vbuf = lds + AL_V + (n & 1) * 8192;
        const int minrel = tw0 - (kb + 63), maxrel = tw0 + 31 - kb;
        const unsigned win = is_slc ? 0x7fffffffu : 512u;
        const bool lane_on = is_slc ? ((selw >> j) & 1u) != 0u : true;
        if (maxrel >= 0 && (is_slc || minrel < 512) && __any(lane_on)) {
            f32x16 p0, p1; qk_tile(kbuf, qf, q, hi, p0, p1);
            if (minrel >= 113 && (is_slc || maxrel < 512)) softmax_tile<true>(p0, p1, 0, win, lane_on, tab, bfar, m, l, o0, o1);
            else softmax_tile<false>(p0, p1, tq - kb - 4 * hi, win, lane_on, tab, bfar, m, l, o0, o1);
            pv_tile(vbuf, p0, p1, o0, o1, lane);
        }
        if (n + 1 < ntile) tile_store(lds + AL_K + ((n + 1) & 1) * 8192, lds + AL_V + ((n + 1) & 1) * 8192, tid, kr, vr);
        __syncthreads();
    }
    branch_fold(o0, o1, l, gate[2], oc0, oc1);
    store_o8(lds + AL_OST + w * 4096, oc0, oc1, (unsigned char*)(F.ws + WS_Y) + (tokb + tw0) * 1024 + 512 + (g * 4 + hq) * 64, lane);
}

constexpr int CL_A = 0  , CL_HID = 69632  ;
__device__ __forceinline__ float gelu_tanh(float x) { const float u = 0.7978845608028654f * (x + 0.044715f * x * x * x); const float t = __builtin_amdgcn_exp2f(2.0f * LOG2E * u); return 0.5f * x * (2.0f - 2.0f * __builtin_amdgcn_rcpf(t + 1.0f)); }
__device__ __forceinline__ void compress_unit(Frame& F, int U) {
    const int b = U >> 4, g = (U >> 3) & 1, kv = (U >> 2) & 1, c0 = 32 * (U & 3);
    const int tid = F.tid, lane = F.lane, w = F.wave; LAS unsigned char* lds = F.lds;
    const bf16_t* src = (const bf16_t*)(F.ws + WS_KVC) + (size_t)b * SEQ * 256 + kv * 128 + g * 64;
    for (int idx = tid; idx < 528 * 8; idx += 512) { const int t = idx >> 3, c = idx & 7; int tok = 16 * c0 + t; if (tok > SEQ - 1) tok = SEQ - 1;
        *(LAS u32x4*)(lds + CL_A + t * 128 + ((c ^ ((t >> 4) & 7)) << 4)) = *(const u32x4*)(src + (size_t)tok * 256 + c * 8); }
    const bf16_t* w1t = (const bf16_t*)(F.ws + WS_CW1) + ((size_t)kv * 128 + 16 * w + (lane & 15)) * 2048 + 8 * (lane >> 4);
    bf16x8 bq[2][16];
#pragma unroll
    for (int j = 0; j < 16; ++j) bq[0][j] = *(const bf16x8*)(w1t + 32 * j);
    __syncthreads();
    f32x4 acc[2]; acc[0] = (f32x4){0.f, 0.f, 0.f, 0.f}; acc[1] = acc[0];
    const int m = lane & 15, kq = lane >> 4;
#pragma unroll
    for (int bt = 0; bt < 4; ++bt) {
        if (bt < 3) {
#pragma unroll
            for (int j = 0; j < 16; ++j) bq[(bt + 1) & 1][j] = *(const bf16x8*)(w1t + 32 * (16 * (bt + 1) + j)); }
#pragma unroll
        for (int j = 0; j < 16; ++j) { const int st = 16 * bt + j, lt = st >> 1, ch = 4 * (st & 1) + kq;
#pragma unroll
            for (int mt = 0; mt < 2; ++mt) { const int t = 256 * mt + 16 * m + lt;
                const bf16x8 af = *(const LAS bf16x8*)(lds + CL_A + t * 128 + ((ch ^ ((t >> 4) & 7)) << 4));
                acc[mt] = __builtin_amdgcn_mfma_f32_16x16x32_bf16(af, bq[bt & 1][j], acc[mt], 0, 0, 0); } }
    }
    { const float b1 = ((const float*)(F.ws + WS_B1))[kv * 128 + 16 * w + (lane & 15)]; LAS bf16_t* hid = (LAS bf16_t*)(lds + CL_HID);
#pragma unroll
      for (int mt = 0; mt < 2; ++mt)
#pragma unroll
          for (int r = 0; r < 4; ++r) { const float v = gelu_tanh(acc[mt][r] + b1); hid[(16 * mt + 4 * (lane >> 4) + r) * 136 + 16 * w + (lane & 15)] = (bf16_t)(pk2(v, 0.f) & 0xffffu); } }
    __syncthreads();
    { const int mt2 = w >> 2, nt2 = w & 3; const LAS bf16_t* hid = (const LAS bf16_t*)(lds + CL_HID) + (16 * mt2 + (lane & 15)) * 136 + 8 * (lane >> 4);
      bf16_t* dst = (bf16_t*)(F.ws + (kv ? WS_VC : WS_KC)) + (size_t)(b * 2 + g) * 128 * 64;
      f32x4 a2 = (f32x4){0.f, 0.f, 0.f, 0.f};
      const bf16_t* w2t = (const bf16_t*)(F.ws + WS_CW2) + ((size_t)kv * 64 + 16 * nt2 + (lane & 15)) * 128 + 8 * (lane >> 4);
#pragma unroll
      for (int s2 = 0; s2 < 4; ++s2) { const bf16x8 af = *(const LAS bf16x8*)(hid + 32 * s2); const bf16x8 bf = *(const bf16x8*)(w2t + 32 * s2); a2 = __builtin_amdgcn_mfma_f32_16x16x32_bf16(af, bf, a2, 0, 0, 0); }
#pragma unroll
      for (int r = 0; r < 4; ++r) { const int c = c0 + 16 * mt2 + 4 * (lane >> 4) + r; const float v = c < 127 ? a2[r] : 0.f; dst[(size_t)c * 64 + 16 * nt2 + (lane & 15)] = (bf16_t)(pk2(v, 0.f) & 0xffffu); } }
    __syncthreads();
}

constexpr int HB_ROW = 2064, HB_HI = 0, HB_LO = 16 * HB_ROW, RT_RED = 2 * 16 * HB_ROW;
static_assert(RT_RED + 8 * 16 * 32 * 4 <= 131072, "router LDS");
__device__ __forceinline__ void ln1_router_panel(Frame& F, const int pm) {
    LAS unsigned char* lds = F.lds;
    const int lane = F.lane, w = F.wave;
    f32x4 gv[4], bv[4];
#pragma unroll
    for (int j = 0; j < 4; ++j) { gv[j] = *((const f32x4*)F.in[14] + lane + 64 * j); bv[j] = *((const f32x4*)F.in[15] + lane + 64 * j); }
    const float brt = F.in[17][lane & 31];
    bf16x8 Ahi[2][4], Alo[2][4];
#pragma unroll
    for (int mb = 0; mb < 2; ++mb)
#pragma unroll
        for (int ks = 0; ks < 4; ++ks) { const float* wp = F.in[16] + (size_t)(128 * w + 32 * ks + 8 * (lane >> 4)) * 32 + 16 * mb + (lane & 15);
            u32x4 hw, lw; float a[8];
#pragma unroll
            for (int i = 0; i < 8; ++i) a[i] = wp[32 * i];
            hw.x = pk2(a[0], a[1]); hw.y = pk2(a[2], a[3]); hw.z = pk2(a[4], a[5]); hw.w = pk2(a[6], a[7]);
            lw.x = pk2(a[0] - bflo(hw.x), a[1] - bfhi(hw.x)); lw.y = pk2(a[2] - bflo(hw.y), a[3] - bfhi(hw.y)); lw.z = pk2(a[4] - bflo(hw.z), a[5] - bfhi(hw.z)); lw.w = pk2(a[6] - bflo(hw.w), a[7] - bfhi(hw.w));
            Ahi[mb][ks] = __builtin_bit_cast(bf16x8, hw); Alo[mb][ks] = __builtin_bit_cast(bf16x8, lw); }
    bf16_t* H = (bf16_t*)(F.ws + WS_H); int* list = (int*)(F.ws + WS_LIST); int* tokslot = (int*)(F.ws + WS_TOKSLOT); float* tokgate = (float*)(F.ws + WS_TOKGATE);
    f32x4 xn[2][4]; u32x2 mn[2][4];
#define RT_ISSUE(batch) do { _Pragma("unroll") for (int tt = 0; tt < 2; ++tt) { const int row_ = pm * 256 + 16 * (batch) + 2 * w + tt; \
        const f32x4* xr_ = (const f32x4*)(F.in[0] + (size_t)row_ * DM) + lane; const u32x2* mr_ = (const u32x2*)((const bf16_t*)F.out + (size_t)row_ * DM) + lane; \
        _Pragma("unroll") for (int j = 0; j < 4; ++j) { xn[tt][j] = __builtin_nontemporal_load(xr_ + 64 * j); mn[tt][j] = mr_[64 * j]; } } } while (0)
    RT_ISSUE(0);
#pragma nounroll
    for (int batch = 0; batch < 16; ++batch) {
        float hsc[2];
#pragma unroll
        for (int tt = 0; tt < 2; ++tt) {
            const int row = pm * 256 + 16 * batch + 2 * w + tt;
            f32x4 v[4]; float s = 0.f;
#pragma unroll
            for (int j = 0; j < 4; ++j) { const u32x2 mw = mn[tt][j]; v[j] = xn[tt][j] * ALPHA + (f32x4){bflo(mw.x), bfhi(mw.x), bflo(mw.y), bfhi(mw.y)}; s += (v[j][0] + v[j][1]) + (v[j][2] + v[j][3]); }
            const float mean = wave_sum(s) * (1.f / DM); float s2 = 0.f;
#pragma unroll
            for (int j = 0; j < 4; ++j) { v[j] = v[j] - mean; s2 += (v[j][0] * v[j][0] + v[j][1] * v[j][1]) + (v[j][2] * v[j][2] + v[j][3] * v[j][3]); }
            const float rstd = 1.f / sqrtf(wave_sum(s2) * (1.f / DM) + LN_EPS);
            u32x2* ho = (u32x2*)(H + (size_t)row * DM) + lane; float amax = 0.f;
            LAS unsigned char* hb = lds + (2 * w + tt) * HB_ROW + 8 * lane;
#pragma unroll
            for (int j = 0; j < 4; ++j) { v[j] = v[j] * rstd * gv[j] + bv[j]; u32x2 wv; wv.x = pk2(v[j][0], v[j][1]); wv.y = pk2(v[j][2], v[j][3]); ho[64 * j] = wv;
                u32x2 lv; lv.x = pk2(v[j][0] - bflo(wv.x), v[j][1] - bfhi(wv.x)); lv.y = pk2(v[j][2] - bflo(wv.y), v[j][3] - bfhi(wv.y));
                *(LAS u32x2*)(hb + HB_HI + 512 * j) = wv; *(LAS u32x2*)(hb + HB_LO + 512 * j) = lv;
                amax = fmaxf(fmaxf(amax, fmaxf(fabsf(v[j][0]), fabsf(v[j][1]))), fmaxf(fabsf(v[j][2]), fabsf(v[j][3]))); }
            amax = wave_max_nonneg(amax);
            hsc[tt] = amax > 0.f ? amax * (1.0f / 127.0f) : 1.0f;
            { const float inv = amax > 0.f ? 127.0f / amax : 0.f;
              unsigned* hq = (unsigned*)(F.ws + WS_HQ + (size_t)row * DM) + lane;
#pragma unroll
              for (int j = 0; j < 4; ++j) hq[64 * j] = pk4(rintf(v[j][0] * inv), rintf(v[j][1] * inv), rintf(v[j][2] * inv), rintf(v[j][3] * inv)); }
        }
        __syncthreads();
        if (batch + 1 < 16) RT_ISSUE(batch + 1);
        { f32x4 acc[2] = {(f32x4){0.f, 0.f, 0.f, 0.f}, (f32x4){0.f, 0.f, 0.f, 0.f}};
          const LAS unsigned char* bp = lds + (lane & 15) * HB_ROW + (128 * w + 8 * (lane >> 4)) * 2;
#pragma unroll
          for (int ks = 0; ks < 4; ++ks) { const bf16x8 bh = *(const LAS bf16x8*)(bp + HB_HI + 64 * ks), bl = *(const LAS bf16x8*)(bp + HB_LO + 64 * ks);
#pragma unroll
              for (int mb = 0; mb < 2; ++mb) { acc[mb] = __builtin_amdgcn_mfma_f32_16x16x32_bf16(Alo[mb][ks], bh, acc[mb], 0, 0, 0); acc[mb] = __builtin_amdgcn_mfma_f32_16x16x32_bf16(Ahi[mb][ks], bl, acc[mb], 0, 0, 0);
                  acc[mb] = __builtin_amdgcn_mfma_f32_16x16x32_bf16(Ahi[mb][ks], bh, acc[mb], 0, 0, 0); } }
#pragma unroll
          for (int mb = 0; mb < 2; ++mb) *(LAS f32x4*)(lds + RT_RED + w * 2048 + (lane & 15) * 128 + (16 * mb + 4 * (lane >> 4)) * 4) = acc[mb]; }
        __syncthreads();
        float logit = brt;
#pragma unroll
        for (int w2 = 0; w2 < 8; ++w2) logit += *(const LAS float*)(lds + RT_RED + w2 * 2048 + (2 * w) * 128 + lane * 4);
        const int e_me = lane & 31; const bool upper = lane >= 32; int rank = 0;
#pragma unroll
        for (int e2 = 0; e2 < 32; ++e2) { const float va = __uint_as_float((unsigned)__builtin_amdgcn_readlane((int)__float_as_uint(logit), e2)), vb = __uint_as_float((unsigned)__builtin_amdgcn_readlane((int)__float_as_uint(logit), 32 + e2));
            const float v2 = upper ? vb : va; rank += (v2 > logit || (v2 == logit && e2 < e_me)) ? 1 : 0; }
        float tv[2][4]; int te[2][4];
#pragma unroll
        for (int k = 0; k < 4; ++k) { const unsigned long long mk = __ballot(rank == k);
            const int sa = __builtin_amdgcn_readfirstlane((int)__ffs((int)(unsigned)(mk & 0xffffffffull)) - 1), sb = __builtin_amdgcn_readfirstlane((int)__ffs((int)(unsigned)(mk >> 32)) - 1);
            tv[0][k] = __uint_as_float((unsigned)__builtin_amdgcn_readlane((int)__float_as_uint(logit), sa)); te[0][k] = sa;
            tv[1][k] = __uint_as_float((unsigned)__builtin_amdgcn_readlane((int)__float_as_uint(logit), 32 + sb)); te[1][k] = sb; }
        float ex[2][4], es[2] = {0.f, 0.f};
#pragma unroll
        for (int tt = 0; tt < 2; ++tt)
#pragma unroll
            for (int k = 0; k < 4; ++k) { ex[tt][k] = __builtin_amdgcn_exp2f((tv[tt][k] - tv[tt][0]) * LOG2E); es[tt] += ex[tt][k]; }
        if ((lane & 31) < 4) {
            const int k = lane & 3, tt = lane >> 5, row = pm * 256 + 16 * batch + 2 * w + tt;
            const int ea = k == 0 ? te[0][0] : k == 1 ? te[0][1] : k == 2 ? te[0][2] : te[0][3], eb = k == 0 ? te[1][0] : k == 1 ? te[1][1] : k == 2 ? te[1][2] : te[1][3];
            const float xa = k == 0 ? ex[0][0] : k == 1 ? ex[0][1] : k == 2 ? ex[0][2] : ex[0][3], xb = k == 0 ? ex[1][0] : k == 1 ? ex[1][1] : k == 2 ? ex[1][2] : ex[1][3];
            const int e = tt ? eb : ea; const float gt = (tt ? xb : xa) / (tt ? es[1] : es[0]);
            const int half = row / HALF_T;
            const unsigned slot = __hip_atomic_fetch_add(F.ctl + CW_CNT + (half * 32 + e) * 16, 1u, RLX_AGENT);
            list[(size_t)(half * 32 + e) * LIST_CAP + slot] = row;
            ((float*)(F.ws + WS_LSCALE))[(size_t)(half * 32 + e) * LIST_CAP + slot] = tt ? hsc[1] : hsc[0];
            tokslot[(size_t)row * 4 + k] = (e << 16) | (int)slot;
            tokgate[(size_t)row * 4 + k] = gt;
        }
    }
#undef RT_ISSUE
}
__device__ __forceinline__ int moe_tables(Frame& F, int half) {
    LAS int* pst = (LAS int*)(F.lds + TAB_PST); LAS int* cnt = (LAS int*)(F.lds + TAB_CNT); LAS int* tile_e = (LAS int*)(F.lds + TAB_TILE);
    __syncthreads();
    if (F.tid < 32) cnt[F.tid] = (int)__hip_atomic_load(F.ctl + CW_CNT + (half * 32 + F.tid) * 16, RLX_AGENT);
    __syncthreads();
    if (F.tid == 0) { int a = 0; for (int e = 0; e < 32; ++e) { pst[e] = a; a += (cnt[e] + 255) >> 8; } pst[32] = a; }
    __syncthreads();
    const int tt = pst[32];
    for (int pm = F.tid; pm < tt; pm += 512) { int e = 0;
#pragma unroll 8
        for (int k = 1; k < 32; ++k) e += (pst[k] <= pm) ? 1 : 0;
        tile_e[pm] = e; }
    __syncthreads();
    return tt;
}
__device__ __forceinline__ void combine_phase(Frame& F, int half) {
    (void)moe_tables(F, half);
    const LAS int* pst = (const LAS int*)(F.lds + TAB_PST);
    const int lane = F.lane, gw = F.bid * NWAVES + F.wave, NGW = F.G * NWAVES;
    f32x4 gv[4], bv[4];
#pragma unroll
    for (int j = 0; j < 4; ++j) { gv[j] = *((const f32x4*)F.in[22] + 2 * lane + (j & 1) + 128 * (j >> 1)); bv[j] = *((const f32x4*)F.in[23] + 2 * lane + (j & 1) + 128 * (j >> 1)); }
    const bf16_t* H = (const bf16_t*)(F.ws + WS_H); const unsigned char* OR = (const unsigned char*)(F.ws + WS_OUTROWS);
    const int* tokslot = (const int*)(F.ws + WS_TOKSLOT); const float* tokgate = (const float*)(F.ws + WS_TOKGATE);
    for (int row = half * HALF_T + gw; row < (half + 1) * HALF_T; row += NGW) {
        f32x4 v[4];
        { const u32x4* hp = (const u32x4*)(H + (size_t)row * DM) + lane;
#pragma unroll
          for (int g = 0; g < 2; ++g) { const u32x4 hw = hp[64 * g]; v[2 * g] = (f32x4){bflo(hw.x), bfhi(hw.x), bflo(hw.y), bfhi(hw.y)} * ALPHA; v[2 * g + 1] = (f32x4){bflo(hw.z), bfhi(hw.z), bflo(hw.w), bfhi(hw.w)} * ALPHA; } }
#pragma unroll
        for (int k = 0; k < 4; ++k) { const int ts = tokslot[(size_t)row * 4 + k]; const float gt = tokgate[(size_t)row * 4 + k];
            const int e = ts >> 16, slot = ts & 0xffff; const size_t orow = (size_t)pst[e] * 256 + slot;
            const u32x2* op = (const u32x2*)(OR + orow * DM) + lane; const float g4 = gt * 0.25f;
#pragma unroll
            for (int g = 0; g < 2; ++g) { const u32x2 ow = op[64 * g];
                const f32x2 a0 = __builtin_amdgcn_cvt_pk_f32_fp8(ow.x, false), a1 = __builtin_amdgcn_cvt_pk_f32_fp8(ow.x, true), a2 = __builtin_amdgcn_cvt_pk_f32_fp8(ow.y, false), a3 = __builtin_amdgcn_cvt_pk_f32_fp8(ow.y, true);
                v[2 * g] += (f32x4){a0.x, a0.y, a1.x, a1.y} * g4; v[2 * g + 1] += (f32x4){a2.x, a2.y, a3.x, a3.y} * g4; } }
        float s = 0.f;
#pragma unroll
        for (int j = 0; j < 4; ++j) s += (v[j][0] + v[j][1]) + (v[j][2] + v[j][3]);
        const float mean = wave_sum(s) * (1.f / DM); float s2 = 0.f;
#pragma unroll
        for (int j = 0; j < 4; ++j) { v[j] = v[j] - mean; s2 += (v[j][0] * v[j][0] + v[j][1] * v[j][1]) + (v[j][2] * v[j][2] + v[j][3] * v[j][3]); }
        const float rstd = 1.f / sqrtf(wave_sum(s2) * (1.f / DM) + LN_EPS);
        f32x4* o = (f32x4*)(F.out + (size_t)row * DM) + 2 * lane;
#pragma unroll
        for (int j = 0; j < 4; ++j) o[(j & 1) + 128 * (j >> 1)] = v[j] * rstd * gv[j] + bv[j];
    }
}
__device__ __forceinline__ void moe_gateup_phase(Frame& F, int half) {
    const int tt = moe_tables(F, half);
    pg8::MoeOrder S; S.init(tt, 8, F.G, F.bid); S.tile_e = (const LAS int*)(F.lds + TAB_TILE);
    pg8::AGather A{(const char*)(F.ws + WS_HQ), (const int*)(F.ws + WS_LIST) + (size_t)half * 32 * LIST_CAP, (const LAS int*)(F.lds + TAB_PST), (const LAS int*)(F.lds + TAB_CNT)};
    pg8::BPlain B{(const char*)(F.ws + WS_WGU), 1024, (size_t)2048 * 1024};
    pg8::EpiSwiglu E{(unsigned char*)(F.ws + WS_ACT), F.in[19], (const float*)(F.ws + WS_WSGU), (const float*)(F.ws + WS_LSCALE) + (size_t)half * 32 * LIST_CAP, (const LAS int*)(F.lds + TAB_PST), (const LAS int*)(F.lds + TAB_CNT)};
    pg8::gemm_phase<pg8::AGather, pg8::BPlain, pg8::EpiSwiglu, pg8::MoeOrder, true, true, 1>(F.lds, A, B, 8, S, E);
}
__device__ __forceinline__ void moe_down_phase(Frame& F, int half) {
    const int tt = moe_tables(F, half);
    pg8::MoeOrder S; S.init(tt, 4, F.G, F.bid); S.tile_e = (const LAS int*)(F.lds + TAB_TILE);
    pg8::ABlk32 A{(const char*)(F.ws + WS_ACT)};
    pg8::BPlain B{(const char*)(F.ws + WS_WDN), 1024, (size_t)1024 * 1024};
    pg8::EpiDown E{(unsigned char*)(F.ws + WS_OUTROWS), F.in[21], (const float*)(F.ws + WS_WSDN)};
    pg8::gemm_phase<pg8::ABlk32, pg8::BPlain, pg8::EpiDown, pg8::MoeOrder, true, true, 2>(F.lds, A, B, 8, S, E);
}


__device__ __forceinline__ void ph_inproj(Frame& F) {
    unsigned char* ws = F.ws;
    pg8::StaticOrder S; S.init(T / 256, 16, F.G, F.bid);
    pg8::APlain A{(const char*)(ws + WS_XB), 1024u}; pg8::BPlain B{(const char*)(ws + WS_WIN), 1024, 0};
    pg8::EpiProj E{ws, (const float*)(ws + WS_BINP), (const float*)(ws + WS_XS), (const float*)(ws + WS_WSIN)};
    pg8::gemm_phase<pg8::APlain, pg8::BPlain, pg8::EpiProj, pg8::StaticOrder, true, true, 1>(F.lds, A, B, 8, S, E);
}
__device__ __forceinline__ void ng_unit(Frame& F, int pm) {
    const int lane = F.lane, w = F.wave, fr = lane & 15, fq = lane >> 4;
    const signed char* xb = (const signed char*)(F.ws + WS_XB) + ((size_t)pm * 256 + 32 * w + fr) * 1024 + 16 * fq;
    const signed char* wb = (const signed char*)(F.ws + WS_WIN) + ((size_t)4096 + fr) * 1024 + 16 * fq;
    i32x4 acc[2][2];
#pragma unroll
    for (int mb = 0; mb < 2; ++mb)
#pragma unroll
        for (int nb = 0; nb < 2; ++nb) acc[mb][nb] = (i32x4){0, 0, 0, 0};
#pragma unroll
    for (int kb4 = 0; kb4 < 4; ++kb4) {
        i32x4 xa[4][2], wa[4][2];
#pragma unroll
        for (int k = 0; k < 4; ++k)
#pragma unroll
            for (int h = 0; h < 2; ++h) { xa[k][h] = *(const i32x4*)(xb + (size_t)h * 16 * 1024 + 64 * (4 * kb4 + k)); wa[k][h] = *(const i32x4*)(wb + (size_t)h * 16 * 1024 + 64 * (4 * kb4 + k)); }
#pragma unroll
        for (int k = 0; k < 4; ++k)
#pragma unroll
            for (int mb = 0; mb < 2; ++mb)
#pragma unroll
                for (int nb = 0; nb < 2; ++nb) acc[mb][nb] = __builtin_amdgcn_mfma_i32_16x16x64_i8(wa[k][mb], xa[k][nb], acc[mb][nb], 0, 0, 0);
    }
    const float* wsc = (const float*)(F.ws + WS_WSIN) + 4096; const float* bia = (const float*)(F.ws + WS_BINP) + 4096; const float* xs = (const float*)(F.ws + WS_XS) + (size_t)pm * 256 + 32 * w;
#pragma unroll
    for (int nb = 0; nb < 2; ++nb) { const float rs = xs[16 * nb + fr]; bf16_t* dst = (bf16_t*)(F.ws + WS_NG) + ((size_t)pm * 256 + 32 * w + 16 * nb + fr) * 32;
#pragma unroll
        for (int mb = 0; mb < 2; ++mb) { const int c = 16 * mb + 4 * fq; const f32x4 sv = *(const f32x4*)(wsc + c), bv = *(const f32x4*)(bia + c);
            const f32x4 v = __builtin_convertvector(acc[mb][nb], f32x4) * (sv * rs) + bv;
            u32x2 o; o.x = pk2(v[0], v[1]); o.y = pk2(v[2], v[3]); *(u32x2*)(dst + c) = o; } }
}
__device__ __forceinline__ void ph_cmp_attnA(Frame& F) {
    for (int pm = F.bid; pm < T / 256; pm += F.G) ng_unit(F, pm);
    for (int U = F.bid; U < 512; U += F.G) compress_unit(F, U);
    build_bias_tab(F); __syncthreads();
    for (int U = F.bid; U < 2048; U += F.G) attnA_unit(F, U);
}
__device__ __forceinline__ void ph_nsa(Frame& F) {
    const bool early = ((F.bid >> 3) & 1) != 0;
    if (early) { for (int it = F.bid; it < N_EXPERT_ITEMS; it += F.G) expert_quant_item(F, it); }
    build_bias_tab(F); __syncthreads();
    for (int U = F.bid; U < 2048; U += F.G) nsa_unit(F, U);
    __syncthreads();
    if (!early) { for (int it = F.bid; it < N_EXPERT_ITEMS; it += F.G) expert_quant_item(F, it); }
}
struct PanelOrder { int pm, nun;
    __device__ __forceinline__ bool next(int i, pg8::Unit& u) const { if (i >= nun) return false; int p = pm; asm volatile("" : "+s"(p)); u.pm = p; u.pn = i; u.e = 0; return true; } };
__device__ __forceinline__ void local_sync(Frame& F) {
    if (F.wave == 0) { __builtin_amdgcn_fence(__ATOMIC_ACQUIRE, "agent"); asm volatile("s_waitcnt vmcnt(0)" ::: "memory"); }
    __syncthreads();
}
__device__ __forceinline__ void ph_chain(Frame& F) {
    unsigned char* ws = F.ws;
    const int pm = F.bid;
    if (pm < T / 256) {
        int nun = 4; asm volatile("" : "+s"(nun));
        PanelOrder S{pm, nun};
        { pg8::APlain A{(const char*)(ws + WS_Y), 1024u}; pg8::BPlain B{(const char*)(ws + WS_WAB), 1024, 0};
          pg8::EpiGate<false> E{(unsigned char*)(ws + WS_MERGED), (const unsigned char*)(ws + WS_MG), (const float*)(ws + WS_WSAB)};
          pg8::gemm_phase<pg8::APlain, pg8::BPlain, pg8::EpiGate<false>, PanelOrder, true, true, 2>(F.lds, A, B, 4, S, E); }
        local_sync(F);
        { pg8::APlain A{(const char*)(ws + WS_Y) + 512, 1024u}; pg8::BPlain B{(const char*)(ws + WS_WAB) + 512, 1024, 0};
          pg8::EpiGate<true> E{(unsigned char*)(ws + WS_MERGED), (const unsigned char*)(ws + WS_MG), (const float*)(ws + WS_WSAB) + 1024};
          pg8::gemm_phase<pg8::APlain, pg8::BPlain, pg8::EpiGate<true>, PanelOrder, true, true, 2>(F.lds, A, B, 4, S, E); }
        local_sync(F);
        { pg8::APlain A{(const char*)(ws + WS_MERGED), 1024u}; pg8::BPlain B{(const char*)(ws + WS_WOUT), 1024, 0};
          pg8::EpiMix E{(bf16_t*)F.out, (const float*)(ws + WS_WSAB) + 2048};
          pg8::gemm_phase<pg8::APlain, pg8::BPlain, pg8::EpiMix, PanelOrder, true, true, 2>(F.lds, A, B, 8, S, E); }
        local_sync(F);
        ln1_router_panel(F, pm);
        __syncthreads();
    }
}

constexpr int NPHASE = 8;
struct Args { const float* in[24]; float* out; unsigned char* ws; int ph_lo, ph_hi; };

__global__ void __launch_bounds__(NWAVES * 64, 2) fwd_kernel(Args args) {
    extern __shared__ __attribute__((aligned(16))) unsigned char lds_raw[];
    Frame F;
    F.lds = (LAS unsigned char*)lds_raw;
    F.tid = threadIdx.x; F.lane = F.tid & 63; F.wave = __builtin_amdgcn_readfirstlane(F.tid >> 6);
    F.G = gridDim.x; F.bid = blockIdx.x;
    F.ws = args.ws; F.ctl = (unsigned*)(args.ws + WS_CTL); F.out = args.out;
#pragma unroll
    for (int k = 0; k < 24; ++k) F.in[k] = args.in[k];
    volatile LAS unsigned* MISC = (volatile LAS unsigned*)(F.lds + MISC_OFF);
    if (F.tid < 64) MISC[F.tid] = 0u;
    __syncthreads();
#if MK_ONE_LAUNCH
    XcdBarrier bar = xcd_barrier_post(F.ctl + CW_BAR, MISC + 8);
#define GRID_BAR() xcd_barrier(bar)
#else
#define GRID_BAR() do { } while (0)
#endif
    const int lo = args.ph_lo, hi = args.ph_hi;
#ifndef PHASE_MASK
#define PHASE_MASK 0xffffffffu
#endif
#define IN(k) (((PHASE_MASK >> (k)) & 1u) && lo <= (k) && (k) < hi)
#define SEAM(k) do { if (IN(k) && IN((k) + 1)) GRID_BAR(); } while (0)
#ifndef REPMASK
#define REPMASK 0u
#endif
#define RUN(k, ...) do { if (IN(k)) { __VA_ARGS__; if constexpr (((REPMASK) >> (k)) & 1u) { GRID_BAR(); __VA_ARGS__; } } SEAM(k); } while (0)

    RUN(0, p0_prologue(F));
    RUN(1, ph_inproj(F));
    RUN(2, ph_cmp_attnA(F));
    RUN(3, ph_nsa(F));
    RUN(4, ph_chain(F));
    RUN(5, moe_gateup_phase(F, 0));
    RUN(6, moe_down_phase(F, 0));
    RUN(7, combine_phase(F, 0));
#undef IN
#undef SEAM
}

extern "C" void kernel_launch(void* const* d_in, const int* in_sizes, int n_in, void* d_out, int out_size, void* d_ws, size_t ws_size, hipStream_t stream) {
    static int grid = 0;
    if (grid == 0) {
        if (n_in != 24 || out_size != T * DM || ws_size < WS_END) { fprintf(stderr, "kernel_launch: unexpected sizes (n_in %d out %d ws %zu)\n", n_in, out_size, ws_size); grid = -1; return; }
        int dev = 0, cus = 0, per_cu = 0;
        if (hipGetDevice(&dev) != hipSuccess || hipDeviceGetAttribute(&cus, hipDeviceAttributeMultiprocessorCount, dev) != hipSuccess) { grid = -1; return; }
        if (hipFuncSetAttribute((const void*)fwd_kernel, hipFuncAttributeMaxDynamicSharedMemorySize, LDS_BYTES) != hipSuccess) { fprintf(stderr, "kernel_launch: hipFuncSetAttribute failed\n"); grid = -1; return; }
        if (hipOccupancyMaxActiveBlocksPerMultiprocessor(&per_cu, (const void*)fwd_kernel, NWAVES * 64, LDS_BYTES) != hipSuccess || per_cu < 1) fprintf(stderr, "kernel_launch: occupancy query reports %d\n", per_cu);
        (void)hipGetLastError();
        grid = cus;
    }
    if (grid < 0) return;
    (void)hipMemsetAsync((char*)d_ws + WS_CTL, 0, CTL_ZERO_BYTES, stream);
    Args a{};
    for (int i = 0; i < 24; ++i) a.in[i] = (const float*)d_in[i];
    a.out = (float*)d_out; a.ws = (unsigned char*)d_ws;
#if MK_ONE_LAUNCH
    a.ph_lo = 0; a.ph_hi = NPHASE;
    hipLaunchKernelGGL(fwd_kernel, dim3(grid), dim3(NWAVES * 64), LDS_BYTES, stream, a);
#else
    for (int p = 0; p < NPHASE; ++p) { a.ph_lo = p; a.ph_hi = p + 1; hipLaunchKernelGGL(fwd_kernel, dim3(grid), dim3(NWAVES * 64), LDS_BYTES, stream, a); }
#endif
}
```

```cpp
#include <hip/hip_runtime.h>
#include <cstdio>
#include <cstdint>
#include <type_traits>

#ifndef MK_ONE_LAUNCH
#define MK_ONE_LAUNCH 1
#endif

#define LAS __attribute__((address_space(3)))
#define GAS __attribute__((address_space(1)))
typedef unsigned short bf16_t;
typedef short bf16x8 __attribute__((ext_vector_type(8)));
typedef short s16x4 __attribute__((ext_vector_type(4)));
typedef float f32x2 __attribute__((ext_vector_type(2)));
typedef float f32x4 __attribute__((ext_vector_type(4)));
typedef float f32x16 __attribute__((ext_vector_type(16)));
typedef unsigned u32x2 __attribute__((ext_vector_type(2)));
typedef unsigned u32x4 __attribute__((ext_vector_type(4)));
typedef int i32x4 __attribute__((ext_vector_type(4)));
typedef int i32x8 __attribute__((ext_vector_type(8)));
typedef __bf16 bf16x2_t __attribute__((ext_vector_type(2)));

constexpr int BATCH = 32, SEQ = 2048, DM = 1024, T = BATCH * SEQ;
constexpr int NE = 32, DFF = 1024;
constexpr int NPROJ = 4352;
constexpr int HALF_T = T;
constexpr int LIST_CAP = HALF_T;
constexpr int MAX_RT = 1056;
constexpr float LN_EPS = 1e-5f;
constexpr float ALPHA = 1.189207115002721f;
constexpr float LOG2E = 1.4426950408889634f;
constexpr float C2 = 0.125f * LOG2E;
constexpr int NWAVES = 8;

constexpr size_t MiB = (size_t)1 << 20;
constexpr size_t WS_CTL = 0, CTL_ZERO_BYTES = 1 * MiB;
constexpr size_t WS_LIST = 1 * MiB;
constexpr size_t WS_TOKSLOT = 9 * MiB;
constexpr size_t WS_TOKGATE = 10 * MiB;
constexpr size_t WS_BINP = 11 * MiB;
constexpr size_t WS_B1 = 11 * MiB + 32 * 1024;
constexpr size_t WS_XS = 11 * MiB + 64 * 1024;
constexpr size_t WS_WSIN = 11 * MiB + 512 * 1024;
constexpr size_t WS_WSGU = 11 * MiB + 768 * 1024;
constexpr size_t WS_WSDN = 14 * MiB + 512 * 1024;
constexpr size_t WS_WSAB = 14 * MiB + 768 * 1024;
constexpr size_t WS_HS = 14 * MiB;
constexpr size_t WS_KC = 12 * MiB;
constexpr size_t WS_VC = 13 * MiB;
constexpr size_t WS_WIN = 16 * MiB;
constexpr size_t WS_WAB = 25 * MiB;
constexpr size_t WS_WOUT = 27 * MiB;
constexpr size_t WS_CW1 = 29 * MiB;
constexpr size_t WS_CW2 = 30 * MiB;
constexpr size_t WS_WGU = 32 * MiB;
constexpr size_t WS_WDN = 160 * MiB;
constexpr size_t WS_H = 224 * MiB;
constexpr size_t WS_D = 352 * MiB;
constexpr size_t WS_XB = WS_D;
constexpr size_t WS_Y = WS_D + 64 * MiB;
constexpr size_t WS_QA = WS_D + 128 * MiB;
constexpr size_t WS_KVA = WS_D + 192 * MiB;
constexpr size_t WS_QB = WS_D + 224 * MiB;
constexpr size_t WS_KVC = WS_D + 288 * MiB;
constexpr size_t WS_MG = WS_D + 384 * MiB;
constexpr size_t WS_NG = WS_D + 640 * MiB;
constexpr size_t WS_MERGED = WS_D + 128 * MiB;
constexpr size_t WS_ACT = WS_D;
constexpr size_t WS_OUTROWS = WS_D + 264 * MiB;
constexpr size_t WS_HQ = WS_D + 544 * MiB;
constexpr size_t WS_LSCALE = WS_D + 608 * MiB;
constexpr size_t WS_END = WS_D + 672 * MiB;
static_assert(WS_NG + (size_t)T * 32 * 2 <= WS_END && WS_OUTROWS + 264 * MiB <= WS_HQ, "ws map");
constexpr int CW_BAR = 4096;
constexpr int CW_CNT = 16384;

constexpr int LDS_BYTES = 151552;
constexpr int LDSCTL_OFF = 132096;
constexpr int MISC_OFF = LDSCTL_OFF;
constexpr int TAB_PST = LDSCTL_OFF + 256;
constexpr int TAB_CNT = TAB_PST + 160;
constexpr int TAB_TILE = TAB_CNT + 128;
constexpr int SIDE_OFF = 139264;
static_assert(TAB_TILE + MAX_RT * 4 <= SIDE_OFF && SIDE_OFF + 3 * 4096 <= LDS_BYTES, "lds map");

#define LDS_WAIT() asm volatile("s_waitcnt lgkmcnt(0)" ::: "memory")
#define VM_WAIT() asm volatile("s_waitcnt vmcnt(0)" ::: "memory")
#define RLX_AGENT __ATOMIC_RELAXED, __HIP_MEMORY_SCOPE_AGENT

__device__ __forceinline__ unsigned pk2(float lo, float hi) { f32x2 v = {lo, hi}; bf16x2_t b = __builtin_convertvector(v, bf16x2_t); return __builtin_bit_cast(unsigned, b); }
__device__ __forceinline__ unsigned pk4(float a, float b, float c, float d) {
    return ((unsigned)(int)a & 255u) | (((unsigned)(int)b & 255u) << 8) | (((unsigned)(int)c & 255u) << 16) | ((unsigned)(int)d << 24); }
__device__ __forceinline__ unsigned pk4u(float a, float b, float c, float d) {
    return (unsigned)(int)a | ((unsigned)(int)b << 8) | ((unsigned)(int)c << 16) | ((unsigned)(int)d << 24); }
__device__ __forceinline__ float bflo(unsigned w) { return __uint_as_float(w << 16); }
__device__ __forceinline__ float bfhi(unsigned w) { return __uint_as_float(w & 0xffff0000u); }
__device__ __forceinline__ float fsigmoid(float x) { return __builtin_amdgcn_rcpf(1.0f + __builtin_amdgcn_exp2f(-x * LOG2E)); }
template <int CTRL, int RMASK> __device__ __forceinline__ float dpp_f(float old, float v) {
    return __uint_as_float((unsigned)__builtin_amdgcn_update_dpp((int)__float_as_uint(old), (int)__float_as_uint(v), CTRL, RMASK, 0xf, false)); }
__device__ __forceinline__ float wave_sum(float v) {
    v += dpp_f<0xB1, 0xf>(v, v); v += dpp_f<0x4E, 0xf>(v, v); v += dpp_f<0x141, 0xf>(v, v); v += dpp_f<0x140, 0xf>(v, v);
    v += dpp_f<0x142, 0xa>(0.f, v); v += dpp_f<0x143, 0xc>(0.f, v);
    return __uint_as_float((unsigned)__builtin_amdgcn_readlane((int)__float_as_uint(v), 63));
}
__device__ __forceinline__ float wave_max_nonneg(float v) {
    v = fmaxf(v, dpp_f<0xB1, 0xf>(v, v)); v = fmaxf(v, dpp_f<0x4E, 0xf>(v, v)); v = fmaxf(v, dpp_f<0x141, 0xf>(v, v)); v = fmaxf(v, dpp_f<0x140, 0xf>(v, v));
    v = fmaxf(v, dpp_f<0x142, 0xa>(0.f, v)); v = fmaxf(v, dpp_f<0x143, 0xc>(0.f, v));
    return __uint_as_float((unsigned)__builtin_amdgcn_readlane((int)__float_as_uint(v), 63));
}

#define XB_TMO      128
#define XB_XCNT(j)  (256  + 64 * (j))
#define XB_XSUB(j)  (1280 + 64 * (j))
#define XB_XGEN(j)  (2304 + 64 * (j))
#define XB_TOP      3328
#define XB_TOPGEN   3392
#define XCD_BAR_WORDS 3456
#define XB_SPIN_CAP (1u << 18)
__device__ __forceinline__ unsigned xb_ld(unsigned* p)              { return __hip_atomic_load(p, __ATOMIC_RELAXED, __HIP_MEMORY_SCOPE_AGENT); }
__device__ __forceinline__ unsigned xb_add(unsigned* p, unsigned v) { return __hip_atomic_fetch_add(p, v, __ATOMIC_RELAXED, __HIP_MEMORY_SCOPE_AGENT); }
__device__ __forceinline__ unsigned xb_xcc_id() { return (unsigned)__builtin_amdgcn_s_getreg((3 << 11) | 20) & 0xFu; }
#define XB_SPIN(cond, bar) do { unsigned _sp = 0; while (cond) { __builtin_amdgcn_s_sleep(1); \
    if ((++_sp & 255u) == 0u) { if (xb_ld(&(bar)[XB_TMO])) break; if (_sp > XB_SPIN_CAP) { atomicAdd(&(bar)[XB_TMO], 1u); break; } } } } while (0)
struct XcdBarrier { unsigned* bar; unsigned x; volatile LAS unsigned* st; };
__device__ __forceinline__ XcdBarrier xcd_barrier_post(unsigned* bar, volatile LAS unsigned* st) {
    XcdBarrier b; b.bar = bar; b.x = xb_xcc_id(); b.st = st;
    if (threadIdx.x == 0) (void)xb_add(&bar[XB_XCNT(b.x)], 1u);
    return b;
}
__device__ __forceinline__ void xcd_barrier_complete(unsigned* bar, unsigned x, unsigned& nloc, unsigned& nx) {
    const unsigned G = gridDim.x * gridDim.y * gridDim.z;
    unsigned sum, cnt, mine, sp = 0u;
    for (;;) {
        sum = 0u; cnt = 0u; mine = 0u;
#pragma unroll
        for (unsigned j = 0; j < 16; ++j) { const unsigned c = xb_ld(&bar[XB_XCNT(j)]); sum += c; cnt += (c > 0u) ? 1u : 0u; mine = (j == x) ? c : mine; }
        if (sum == G) break;
        __builtin_amdgcn_s_sleep(1);
        if ((++sp & 255u) == 0u) { if (xb_ld(&bar[XB_TMO])) break; if (sp > XB_SPIN_CAP) { atomicAdd(&bar[XB_TMO], 1u); break; } }
    }
    nloc = mine > 0u ? mine : 1u; nx = cnt > 0u ? cnt : 1u;
}
__device__ __forceinline__ void xcd_barrier(const XcdBarrier& b) {
    asm volatile("s_waitcnt vmcnt(0)" ::: "memory");
    __syncthreads();
    if (threadIdx.x == 0) {
        unsigned* bar = b.bar;
        __builtin_amdgcn_s_waitcnt(0);
        unsigned nloc = b.st[0], nx = b.st[1];
        if (nloc == 0u) { xcd_barrier_complete(bar, b.x, nloc, nx); b.st[0] = nloc; b.st[1] = nx; }
        const unsigned old = xb_add(&bar[XB_XSUB(b.x)], 1u);
        const unsigned gen = old / nloc;
        if (old + 1u == (gen + 1u) * nloc) {
            __builtin_amdgcn_fence(__ATOMIC_RELEASE, "agent");
            asm volatile("s_waitcnt vmcnt(0)" ::: "memory");
            const unsigned og = xb_add(&bar[XB_TOP], 1u);
            const unsigned tg = og / nx;
            if (og + 1u == (tg + 1u) * nx) xb_add(&bar[XB_TOPGEN], 1u);
            else XB_SPIN(xb_ld(&bar[XB_TOPGEN]) == tg, bar);
            __builtin_amdgcn_fence(__ATOMIC_ACQUIRE, "agent");
            xb_add(&bar[XB_XGEN(b.x)], 1u);
            asm volatile("s_waitcnt vmcnt(0)" ::: "memory");
        } else {
            XB_SPIN(xb_ld(&bar[XB_XGEN(b.x)]) == gen, bar);
            __builtin_amdgcn_fence(__ATOMIC_ACQUIRE, "agent");
            asm volatile("s_waitcnt vmcnt(0)" ::: "memory");
        }
    }
    __syncthreads();
}

namespace pg8 {
constexpr int BM = 256, BK = 64, HALF = 128, HTB = HALF * BK * 2, STAGE_BYTES = 8 * HTB, NXCD = 8, WGM = 8;
__host__ __device__ __forceinline__ int lds_byte(int r, int c) { const int st = (r >> 4) * 2 + (c >> 5), rr = r & 15, cc = c & 31, ob = rr * 64 + cc * 2; return st * 1024 + (ob ^ (((ob >> 9) & 1) << 5)); }
__host__ __device__ __forceinline__ void stage_rc(int b, int& R, int& C) { const int st = b / 1024, sb = b % 1024, swz = sb ^ (((sb >> 9) & 1) << 5); R = (st >> 1) * 16 + swz / 64; C = (st & 1) * 32 + (swz % 64) / 2; }
__host__ __device__ __forceinline__ int perm32(int rho) { const int n = rho >> 4, i = rho & 15; return 8 * (i >> 2) + 4 * n + (i & 3); }

__host__ __device__ __forceinline__ int perm_wide(int R) { const int bj = R >> 7, wc = (R >> 5) & 3, n = (R >> 4) & 1, fq = (R >> 2) & 3, j = R & 3; return wc * 64 + fq * 16 + bj * 8 + n * 4 + j; }
struct Unit { int pm, pn, e; };
__device__ __forceinline__ u32x4 pair_rows16(const u32x2 X, const u32x2 Y) {
    const auto rx = __builtin_amdgcn_permlane16_swap(X.x, Y.x, false, false), ry = __builtin_amdgcn_permlane16_swap(X.y, Y.y, false, false);
    u32x4 w; w.x = rx[0]; w.y = ry[0]; w.z = rx[1]; w.w = ry[1]; return w; }

struct StaticOrder {
    int nM, nN, nwg, G, c;
    __device__ void init(int nM_, int nN_, int G_, int c_) { nM = nM_; nN = nN_; nwg = nM * nN; G = G_; c = c_; }
    __device__ __forceinline__ bool next(int i, Unit& u) const {
        const long L = (long)i * G + c; if (L >= nwg) return false;
        int wgid = (int)L; { const int q = nwg / NXCD, r = nwg % NXCD, xcd = wgid % NXCD, off = wgid / NXCD; wgid = (xcd < r ? xcd * (q + 1) : r * (q + 1) + (xcd - r) * q) + off; }
        const int nig = WGM * nN, gid = wgid / nig, fm = gid * WGM, gsz = (nM - fm) < WGM ? (nM - fm) : WGM;
        u.pm = fm + ((wgid % nig) % gsz); u.pn = (wgid % nig) / gsz; u.e = 0; return true;
    }
};
struct MoeOrder : StaticOrder {
    const LAS int* tile_e;
    __device__ __forceinline__ bool next(int i, Unit& u) const {
        if (!StaticOrder::next(i, u)) return false;
        u.e = __builtin_amdgcn_readfirstlane(tile_e[u.pm]); return true;
    }
};
struct APlain { const char* base; unsigned ldab;
    static constexpr bool GATHER = false; static constexpr size_t KSTEP = BK * 2;
    static __device__ __forceinline__ unsigned coloff(unsigned cb) { return cb; }
    __device__ __forceinline__ const int* gptr(const Unit&, int) const { return nullptr; }
    __device__ __forceinline__ unsigned rowoff(const Unit& u, int r, const LAS int*) const { return (unsigned)(u.pm * BM + r) * ldab; } };
struct AGather { const char* base; const int* list; const LAS int* pst; const LAS int* cnt;
    static constexpr bool GATHER = true; static constexpr size_t KSTEP = BK * 2;
    static __device__ __forceinline__ unsigned coloff(unsigned cb) { return cb; }
    __device__ __forceinline__ const int* gptr(const Unit& u, int tid) const {
        int lr = (u.pm - pst[u.e]) * BM + (tid & 255); if (lr >= cnt[u.e]) lr = 0; return list + (size_t)u.e * LIST_CAP + lr; }
    __device__ __forceinline__ unsigned rowoff(const Unit&, int r, const LAS int* stok) const { return (unsigned)stok[r] * 1024u; } };
__host__ __device__ __forceinline__ size_t bl32_off(int row, int col) { return (size_t)(row >> 8) * 262144 + (size_t)(col >> 5) * 8192 + (size_t)(row & 255) * 32 + (col & 31); }
struct ABlk32 { const char* base;
    static constexpr bool GATHER = false; static constexpr size_t KSTEP = 4 * 8192;
    static __device__ __forceinline__ unsigned coloff(unsigned cb) { return (cb >> 5) * 8192u + (cb & 31u); }
    __device__ __forceinline__ const int* gptr(const Unit&, int) const { return nullptr; }
    __device__ __forceinline__ unsigned rowoff(const Unit& u, int r, const LAS int*) const { return (unsigned)u.pm * 262144u + (unsigned)r * 32u; } };
struct BPlain { const char* base; int ldbb  ; size_t estride;
    __device__ __forceinline__ const char* tile(const Unit& u) const { return base + (size_t)u.e * estride + (size_t)u.pn * BM * ldbb; } };
__device__ __forceinline__ f32x4 tof(const f32x4& v) { return v; }
__device__ __forceinline__ f32x4 tof(const i32x4& v) { return __builtin_convertvector(v, f32x4); }

__device__ __forceinline__ unsigned cvt_pk_bf16(float lo, float hi) { return pk2(lo, hi); }

template <class AP, class BP, class Epi, class Sched, bool ALIGN_EPI, bool SP2, int MODE = 0  >
__device__ __forceinline__ void gemm_phase(LAS unsigned char* lds, const AP& A, const BP& B, const int nt  , const Sched& S, const Epi& E) {
    const int tid = threadIdx.x, wid = __builtin_amdgcn_readfirstlane(tid >> 6), lane = tid & 63, wr = wid >> 2, wc = wid & 3, fr = lane & 15, fq = lane >> 4;
    int Rst[2], Cst[2]; unsigned voffB[2];
#pragma unroll
    for (int i = 0; i < 2; ++i) { int R, C; stage_rc(tid * 16 + i * 8192, R, C); Rst[i] = R; Cst[i] = C; const int Rb = (int)Epi::PERM == 2 ? perm_wide(R) : Epi::PERM ? ((R & ~31) + perm32(R & 31)) : R;
        voffB[i] = (unsigned)(Rb * B.ldbb + C * 2); }
    const size_t kstep = (size_t)(BK * 2), kstepA = AP::KSTEP;
    const size_t hstepB = (size_t)((int)Epi::PERM == 2 ? 8 : HALF) * B.ldbb;
    const unsigned ldsw = (unsigned)wid * 1024u;
    const int aoff = lds_byte(wr * 64 + fr, fq * 8), boff = lds_byte(wc * 32 + fr, fq * 8);
#define PG8_SA(b, h) (((b) * 2 + (h)) * HTB)
#define PG8_SB(b, h) ((4 + (b) * 2 + (h)) * HTB)
#define PG8_STAGE(bufoff, gbase, voff) do { _Pragma("unroll") for (int _i = 0; _i < 2; ++_i) \
        __builtin_amdgcn_global_load_lds((const unsigned*)((const char*)(gbase) + (voff)[_i]), (LAS unsigned*)(lds + (bufoff) + ldsw + _i * 8192), 16, 0, 0); } while (0)
#define PG8_LDA(dst, b, h) do { _Pragma("unroll") for (int m = 0; m < 4; ++m) _Pragma("unroll") for (int k = 0; k < 2; ++k) dst[m][k] = *(const LAS bf16x8*)(lds + PG8_SA(b, h) + aoff + m * 2048 + k * 1024); } while (0)
#define PG8_LDB(dst, b, h) do { _Pragma("unroll") for (int n = 0; n < 2; ++n) _Pragma("unroll") for (int k = 0; k < 2; ++k) dst[n][k] = *(const LAS bf16x8*)(lds + PG8_SB(b, h) + boff + n * 2048 + k * 1024); } while (0)
#define PG8_MMA(ai, bj, At, Bt) do { __builtin_amdgcn_s_setprio(1); _Pragma("unroll") for (int m = 0; m < 4; ++m) _Pragma("unroll") for (int n = 0; n < 2; ++n) { \
        if constexpr (MODE == 2) {   \
            const i32x8 bw = __builtin_shufflevector(__builtin_bit_cast(i32x4, Bt[n][0]), __builtin_bit_cast(i32x4, Bt[n][1]), 0, 1, 2, 3, 4, 5, 6, 7); \
            const i32x8 aw = __builtin_shufflevector(__builtin_bit_cast(i32x4, At[m][0]), __builtin_bit_cast(i32x4, At[m][1]), 0, 1, 2, 3, 4, 5, 6, 7); \
            asm volatile("s_nop 1\n\tv_mfma_scale_f32_16x16x128_f8f6f4 %0, %1, %2, %0, %3, %3 op_sel_hi:[0,0,0]" : "+v"(acc[ai][bj][m][n]) : "v"(bw), "v"(aw), "v"(mxsc)); \
        } else { _Pragma("unroll") for (int k = 0; k < 2; ++k) { \
        if constexpr (MODE == 1) acc[ai][bj][m][n] = __builtin_bit_cast(AccV, __builtin_amdgcn_mfma_i32_16x16x64_i8(__builtin_bit_cast(i32x4, Bt[n][k]), __builtin_bit_cast(i32x4, At[m][k]), __builtin_bit_cast(i32x4, acc[ai][bj][m][n]), 0, 0, 0)); \
        else acc[ai][bj][m][n] = __builtin_bit_cast(AccV, __builtin_amdgcn_mfma_f32_16x16x32_bf16(Bt[n][k], At[m][k], __builtin_bit_cast(f32x4, acc[ai][bj][m][n]), 0, 0, 0)); } } } __builtin_amdgcn_s_setprio(0); } while (0)
#define PG8_WAIT_V(n) asm volatile("s_waitcnt vmcnt(" #n ")" ::: "memory")
#define PG8_WAIT_L(n) asm volatile("s_waitcnt lgkmcnt(" #n ")" ::: "memory")
#define PG8_BAR __builtin_amdgcn_s_barrier()
#define PG8_SCHED __builtin_amdgcn_sched_barrier(0)
    Unit cur, nxt; int ui = 0;
    if (!S.next(0, cur)) return;
    typedef typename std::conditional<MODE == 1, i32x4, f32x4>::type AccV;
    AccV acc[2][2][4][2];
#pragma unroll
    for (int a = 0; a < 2; ++a)
#pragma unroll
        for (int b = 0; b < 2; ++b)
#pragma unroll
            for (int m = 0; m < 4; ++m)
#pragma unroll
                for (int n = 0; n < 2; ++n) acc[a][b][m][n] = (AccV){0, 0, 0, 0};
    bf16x8 At[4][2], B0[2][2], B1[2][2];
    const unsigned mxsc = 0x7f7f7f7fu;
    unsigned aoC0[2], aoC1[2], aoN0[2], aoN1[2];
    const char* const Ab = A.base;
    const char* cB = B.tile(cur);
    LAS float* const side = (LAS float*)(lds + SIDE_OFF);
    int sbuf = 0;
#define PG8_SIDE(unit, buf) do { if constexpr (Epi::SIDE) { \
        __builtin_amdgcn_global_load_lds((const unsigned*)E.side_ptr0(unit, tid), (LAS unsigned*)(lds + SIDE_OFF + (buf) * 4096 + wid * 256), 4, 0, 0); \
        if (wid < 4) __builtin_amdgcn_global_load_lds((const unsigned*)E.side_ptr1(unit, tid), (LAS unsigned*)(lds + SIDE_OFF + (buf) * 4096 + 2048 + wid * 256), 4, 0, 0); } \
        if constexpr (AP::GATHER) { if (wid < 4) __builtin_amdgcn_global_load_lds((const unsigned*)A.gptr(unit, tid), (LAS unsigned*)(lds + SIDE_OFF + (buf) * 4096 + 3072 + wid * 256), 4, 0, 0); } } while (0)
    PG8_SIDE(cur, 0);
    if constexpr (AP::GATHER) { PG8_WAIT_V(0); PG8_BAR; }
#pragma unroll
    for (int i = 0; i < 2; ++i) { const LAS int* stok = (const LAS int*)(side + 768); aoC0[i] = A.rowoff(cur, Rst[i], stok) + AP::coloff((unsigned)Cst[i] * 2u); aoC1[i] = A.rowoff(cur, HALF + Rst[i], stok) + AP::coloff((unsigned)Cst[i] * 2u); }
    if constexpr (SP2) {
        PG8_STAGE(PG8_SB(0, 0), cB, voffB); PG8_STAGE(PG8_SB(0, 1), cB + hstepB, voffB); PG8_STAGE(PG8_SA(0, 0), Ab, aoC0); PG8_STAGE(PG8_SA(0, 1), Ab, aoC1);
        if (wr == 1) PG8_BAR;
        PG8_WAIT_V(2); PG8_BAR;
        PG8_STAGE(PG8_SB(1, 0), cB + kstep, voffB); PG8_STAGE(PG8_SA(1, 0), Ab + kstepA, aoC0); PG8_STAGE(PG8_SB(1, 1), cB + hstepB + kstep, voffB);
        PG8_WAIT_V(6); PG8_BAR;
    } else {
        PG8_STAGE(PG8_SB(0, 0), cB, voffB); PG8_STAGE(PG8_SA(0, 0), Ab, aoC0); PG8_STAGE(PG8_SB(0, 1), cB + hstepB, voffB); PG8_STAGE(PG8_SA(0, 1), Ab, aoC1);
        if (wr == 1) PG8_BAR;
        PG8_WAIT_V(4); PG8_BAR;
        PG8_STAGE(PG8_SB(1, 0), cB + kstep, voffB); PG8_STAGE(PG8_SA(1, 0), Ab + kstepA, aoC0); PG8_STAGE(PG8_SB(1, 1), cB + hstepB + kstep, voffB);
        PG8_WAIT_V(6); PG8_BAR;
    }
    for (;;) {
        const bool has_next = S.next(ui + 1, nxt);
        const char* nB = has_next ? B.tile(nxt) : cB;
        const int nbuf = sbuf == 2 ? 0 : sbuf + 1;
        if (has_next) PG8_SIDE(nxt, nbuf);
        if (has_next) {
            if constexpr (!AP::GATHER) {
#pragma unroll
            for (int i = 0; i < 2; ++i) { aoN0[i] = A.rowoff(nxt, Rst[i], nullptr) + AP::coloff((unsigned)Cst[i] * 2u); aoN1[i] = A.rowoff(nxt, HALF + Rst[i], nullptr) + AP::coloff((unsigned)Cst[i] * 2u); } }
        } else {
#pragma unroll
            for (int i = 0; i < 2; ++i) { aoN0[i] = aoC0[i]; aoN1[i] = aoC1[i]; }
        }
#pragma nounroll
        for (int t = 0; t < nt; t += 2) {
            const bool last = (t == nt - 2);
            const char* a1 = Ab + (size_t)(t + 1) * kstepA;
            const char* a2 = last ? Ab : Ab + (size_t)(t + 2) * kstepA; const char* b2 = last ? nB : cB + (size_t)(t + 2) * kstep;
            const char* a3 = a2 + kstepA; const char* b3 = b2 + kstep;
            if constexpr (AP::GATHER) { if (last && has_next) {
                const LAS int* stok = (const LAS int*)(side + nbuf * 1024 + 768);
#pragma unroll
                for (int i = 0; i < 2; ++i) { aoN0[i] = A.rowoff(nxt, Rst[i], stok) + AP::coloff((unsigned)Cst[i] * 2u); aoN1[i] = A.rowoff(nxt, HALF + Rst[i], stok) + AP::coloff((unsigned)Cst[i] * 2u); } } }
            unsigned s0[2], s1[2];
#pragma unroll
            for (int i = 0; i < 2; ++i) { s0[i] = last ? aoN0[i] : aoC0[i]; s1[i] = last ? aoN1[i] : aoC1[i]; }
            if constexpr (SP2) {
            PG8_LDB(B0, 0, 0); PG8_LDB(B1, 0, 1); PG8_SCHED; PG8_LDA(At, 0, 0); PG8_STAGE(PG8_SA(1, 1), a1, aoC1);
            PG8_WAIT_V(8); PG8_WAIT_L(0); PG8_BAR; PG8_MMA(0, 0, At, B0); PG8_MMA(0, 1, At, B1); PG8_BAR; PG8_SCHED;
            PG8_LDA(At, 0, 1); PG8_STAGE(PG8_SB(0, 0), b2, voffB); PG8_STAGE(PG8_SB(0, 1), b2 + hstepB, voffB); PG8_STAGE(PG8_SA(0, 0), a2, s0);
            PG8_WAIT_V(8); PG8_WAIT_L(0); PG8_BAR; PG8_MMA(1, 0, At, B0); PG8_MMA(1, 1, At, B1); PG8_BAR; PG8_SCHED;
            PG8_LDB(B0, 1, 0); PG8_LDB(B1, 1, 1); PG8_SCHED; PG8_LDA(At, 1, 0); PG8_STAGE(PG8_SA(0, 1), a2, s1);
            PG8_WAIT_V(8); PG8_WAIT_L(0); PG8_BAR; PG8_MMA(0, 0, At, B0); PG8_MMA(0, 1, At, B1); PG8_BAR; PG8_SCHED;
            PG8_LDA(At, 1, 1); PG8_STAGE(PG8_SB(1, 0), b3, voffB); PG8_STAGE(PG8_SB(1, 1), b3 + hstepB, voffB); PG8_STAGE(PG8_SA(1, 0), a3, s0);
            PG8_WAIT_V(8); PG8_WAIT_L(0); PG8_BAR; PG8_MMA(1, 0, At, B0); PG8_MMA(1, 1, At, B1); PG8_BAR; PG8_SCHED;
            } else {
            PG8_LDB(B0, 0, 0); PG8_SCHED; PG8_LDA(At, 0, 0); PG8_STAGE(PG8_SA(1, 1), a1, aoC1);
            PG8_WAIT_L(8); PG8_BAR; PG8_WAIT_L(0); PG8_MMA(0, 0, At, B0); PG8_BAR; PG8_SCHED;
            PG8_LDB(B1, 0, 1); PG8_STAGE(PG8_SB(0, 0), b2, voffB);
            PG8_BAR; PG8_WAIT_L(0); PG8_MMA(0, 1, At, B1); PG8_BAR;
            PG8_LDA(At, 0, 1); PG8_STAGE(PG8_SA(0, 0), a2, s0);
            PG8_BAR; PG8_WAIT_L(0); PG8_MMA(1, 0, At, B0); PG8_BAR; PG8_SCHED;
            PG8_STAGE(PG8_SB(0, 1), b2 + hstepB, voffB);
            PG8_WAIT_V(6); PG8_BAR; PG8_MMA(1, 1, At, B1); PG8_BAR;
            PG8_LDB(B0, 1, 0); PG8_SCHED; PG8_LDA(At, 1, 0); PG8_STAGE(PG8_SA(0, 1), a2, s1);
            PG8_WAIT_L(8); PG8_BAR; PG8_WAIT_L(0); PG8_MMA(0, 0, At, B0); PG8_BAR; PG8_SCHED;
            PG8_LDB(B1, 1, 1); PG8_STAGE(PG8_SB(1, 0), b3, voffB);
            PG8_BAR; PG8_WAIT_L(0); PG8_MMA(0, 1, At, B1); PG8_BAR;
            PG8_LDA(At, 1, 1); PG8_STAGE(PG8_SA(1, 0), a3, s0);
            PG8_BAR; PG8_WAIT_L(0); PG8_MMA(1, 0, At, B0); PG8_BAR; PG8_SCHED;
            PG8_STAGE(PG8_SB(1, 1), b3 + hstepB, voffB);
            PG8_WAIT_V(6); PG8_BAR; PG8_MMA(1, 1, At, B1); PG8_BAR;
            }
        }
        if constexpr (MODE == 2) asm volatile("s_nop 15\n\ts_nop 7" ::: "memory");
        if constexpr (ALIGN_EPI) { if (wr == 0) PG8_BAR; }
        E(acc, cur, wr, wc, fr, fq, side + sbuf * 1024);
        if (!has_next) break;
#pragma unroll
        for (int a = 0; a < 2; ++a)
#pragma unroll
            for (int b = 0; b < 2; ++b)
#pragma unroll
                for (int m = 0; m < 4; ++m)
#pragma unroll
                    for (int n = 0; n < 2; ++n) acc[a][b][m][n] = (AccV){0, 0, 0, 0};
        cur = nxt; cB = nB; ++ui; sbuf = nbuf;
#pragma unroll
        for (int i = 0; i < 2; ++i) { aoC0[i] = aoN0[i]; aoC1[i] = aoN1[i]; }
        if constexpr (ALIGN_EPI) { if (wr == 1) PG8_BAR; }
    }
    PG8_WAIT_V(0);
    if constexpr (!ALIGN_EPI) { if (wr == 0) PG8_BAR; }
    PG8_BAR;
#undef PG8_SIDE
#undef PG8_SA
#undef PG8_SB
#undef PG8_STAGE
#undef PG8_LDA
#undef PG8_LDB
#undef PG8_MMA
#undef PG8_WAIT_V
#undef PG8_WAIT_L
#undef PG8_BAR
#undef PG8_SCHED
}


struct EpiProj {
    static constexpr bool PERM = true, SIDE = true;
    __device__ __forceinline__ const float* side_ptr0(const Unit& u, int tid) const { return (tid < 256 ? bias : wsc) + u.pn * 256 + (tid & 255); }
    __device__ __forceinline__ const float* side_ptr1(const Unit& u, int tid) const { return xs + u.pm * BM + (tid & 255); }
    unsigned char* ws; const float* bias; const float* xs; const float* wsc;
    template <class AV> __device__ __forceinline__ void operator()(const AV (&acc)[2][2][4][2], const Unit& u, int wr, int wc, int fr, int fq, const LAS float* sd) const {
        const int pn = u.pn; bf16_t* base; int ld, c0; bool ng = false; const bool gate8 = pn >= 8 && pn < 16;
        if (pn < 2) { base = (bf16_t*)(ws + WS_QA); ld = 512; c0 = pn * 256; }
        else if (pn == 2) { base = (bf16_t*)(ws + WS_KVA); ld = 256; c0 = 0; }
        else if (pn < 5) { base = (bf16_t*)(ws + WS_QB); ld = 512; c0 = (pn - 3) * 256; }
        else if (pn < 8) { base = (bf16_t*)(ws + WS_KVC + (size_t)(pn - 5) * 32 * MiB); ld = 256; c0 = 0; }
        else if (pn < 16) { base = (bf16_t*)(ws + WS_MG); ld = 2048; c0 = (pn - 8) * 256; }
        else { base = (bf16_t*)(ws + WS_NG); ld = 32; c0 = 0; ng = true; }
        const int row0 = u.pm * BM + wr * 64 + fr, ct = wc * 32 + 8 * fq;
        const float qsc = (pn < 2 || pn == 3 || pn == 4) ? C2 : 1.0f;
        f32x4 bv[2][2], sv[2][2]; float rsv[2][4];
#pragma unroll
        for (int bj = 0; bj < 2; ++bj)
#pragma unroll
            for (int n = 0; n < 2; ++n) { bv[bj][n] = *(const LAS f32x4*)(sd + bj * HALF + ct + 4 * n) * qsc; sv[bj][n] = *(const LAS f32x4*)(sd + 256 + bj * HALF + ct + 4 * n) * qsc; }
#pragma unroll
        for (int ai = 0; ai < 2; ++ai)
#pragma unroll
            for (int m = 0; m < 4; ++m) rsv[ai][m] = sd[512 + wr * 64 + fr + ai * HALF + m * 16];
        if (gate8) {
#pragma unroll
            for (int ai = 0; ai < 2; ++ai)
#pragma unroll
                for (int mp = 0; mp < 2; ++mp)
#pragma unroll
                    for (int bj = 0; bj < 2; ++bj) { u32x2 w8[2];
#pragma unroll
                        for (int mm = 0; mm < 2; ++mm) { const int m = 2 * mp + mm; const float rs = rsv[ai][m];
                            const f32x4 v0 = tof(acc[ai][bj][m][0]) * (sv[bj][0] * rs) + bv[bj][0], v1 = tof(acc[ai][bj][m][1]) * (sv[bj][1] * rs) + bv[bj][1];
                            w8[mm].x = pk4u(fsigmoid(v0[0]) * 255.0f + 0.5f, fsigmoid(v0[1]) * 255.0f + 0.5f, fsigmoid(v0[2]) * 255.0f + 0.5f, fsigmoid(v0[3]) * 255.0f + 0.5f);
                            w8[mm].y = pk4u(fsigmoid(v1[0]) * 255.0f + 0.5f, fsigmoid(v1[1]) * 255.0f + 0.5f, fsigmoid(v1[2]) * 255.0f + 0.5f, fsigmoid(v1[3]) * 255.0f + 0.5f); }
                        const int row = row0 + ai * HALF + (2 * mp + (fq & 1)) * 16;
                        *(u32x4*)((unsigned char*)(ws + WS_MG) + (size_t)row * 2048 + c0 + wc * 32 + 8 * (fq & 2) + bj * HALF) = pair_rows16(w8[0], w8[1]); }
        } else {
#pragma unroll
        for (int ai = 0; ai < 2; ++ai)
#pragma unroll
            for (int m = 0; m < 4; ++m) { const int row = row0 + ai * HALF + m * 16; const float rs = rsv[ai][m]; bf16_t* rowp = base + (size_t)row * ld + c0 + ct;
#pragma unroll
                for (int bj = 0; bj < 2; ++bj) { const f32x4 v0 = tof(acc[ai][bj][m][0]) * (sv[bj][0] * rs) + bv[bj][0], v1 = tof(acc[ai][bj][m][1]) * (sv[bj][1] * rs) + bv[bj][1];
                    u32x4 w; w.x = pk2(v0[0], v0[1]); w.y = pk2(v0[2], v0[3]); w.z = pk2(v1[0], v1[1]); w.w = pk2(v1[2], v1[3]);
                    if (!ng || (bj == 0 && wc == 0)) *(u32x4*)(rowp + bj * HALF) = w; } }
        }
    }
};
struct EpiSwiglu {
    static constexpr bool PERM = true, SIDE = true;
    __device__ __forceinline__ const float* side_ptr0(const Unit& u, int tid) const {
        const float* bg = bgu + (size_t)u.e * 2048 + 128 * u.pn;
        return tid < 128 ? bg + tid : tid < 256 ? bg + 1024 + (tid - 128) : wsc + (size_t)u.e * 2048 + 256 * u.pn + (tid - 256); }
    __device__ __forceinline__ const float* side_ptr1(const Unit& u, int tid) const {
        int lr = (u.pm - pst[u.e]) * BM + (tid & 255); if (lr >= cnt[u.e]) lr = 0; return lscale + (size_t)u.e * LIST_CAP + lr; }
    unsigned char* act; const float* bgu;
    const float* wsc; const float* lscale; const LAS int* pst; const LAS int* cnt;
    template <class AV> __device__ __forceinline__ void operator()(const AV (&acc)[2][2][4][2], const Unit& u, int wr, int wc, int fr, int fq, const LAS float* sd) const {
        const int row0 = u.pm * BM + wr * 64 + fr, ct = wc * 32 + 8 * fq;
        f32x4 bgv[2], blv[2], sgv[2], slv[2];
#pragma unroll
        for (int n = 0; n < 2; ++n) { bgv[n] = *(const LAS f32x4*)(sd + ct + 4 * n); blv[n] = *(const LAS f32x4*)(sd + 128 + ct + 4 * n); sgv[n] = *(const LAS f32x4*)(sd + 256 + ct + 4 * n); slv[n] = *(const LAS f32x4*)(sd + 384 + ct + 4 * n); }
#pragma unroll
        for (int ai = 0; ai < 2; ++ai)
#pragma unroll
            for (int mp = 0; mp < 2; ++mp) { u32x2 w2[2];
#pragma unroll
              for (int mm = 0; mm < 2; ++mm) { const int m = 2 * mp + mm; f32x2 o[4]; const float rs = sd[512 + wr * 64 + fr + ai * HALF + m * 16];
#pragma unroll
                for (int n = 0; n < 2; ++n) { const f32x4 sg = sgv[n] * rs, sl = slv[n] * rs; const f32x4 ag = tof(acc[ai][0][m][n]), al = tof(acc[ai][1][m][n]);
#pragma unroll
                    for (int h2 = 0; h2 < 2; ++h2) {
                        const f32x2 g = (f32x2){ag[2 * h2], ag[2 * h2 + 1]} * (f32x2){sg[2 * h2], sg[2 * h2 + 1]} + (f32x2){bgv[n][2 * h2], bgv[n][2 * h2 + 1]};
                        const f32x2 l = (f32x2){al[2 * h2], al[2 * h2 + 1]} * (f32x2){sl[2 * h2], sl[2 * h2 + 1]} + (f32x2){blv[n][2 * h2], blv[n][2 * h2 + 1]};
                        f32x2 glu, lin; glu.x = __builtin_amdgcn_fmed3f(g.x, -24.0f, 7.0f); glu.y = __builtin_amdgcn_fmed3f(g.y, -24.0f, 7.0f); lin.x = __builtin_amdgcn_fmed3f(l.x, -7.0f, 7.0f); lin.y = __builtin_amdgcn_fmed3f(l.y, -7.0f, 7.0f);
                        const f32x2 ea = glu * (-1.702f * LOG2E); f32x2 d; d.x = __builtin_amdgcn_exp2f(ea.x); d.y = __builtin_amdgcn_exp2f(ea.y); d = d + 1.0f;
                        const float rr = __builtin_amdgcn_rcpf(d.x * d.y); const f32x2 r = (f32x2){d.y, d.x} * (f32x2){rr, rr};
                        o[2 * n + h2] = (glu * r) * (lin * 4.0f + 4.0f); } }
                u32x2 w; w.x = __builtin_amdgcn_cvt_pk_fp8_f32(o[0].x, o[0].y, 0, false); w.x = __builtin_amdgcn_cvt_pk_fp8_f32(o[1].x, o[1].y, w.x, true);
                w.y = __builtin_amdgcn_cvt_pk_fp8_f32(o[2].x, o[2].y, 0, false); w.y = __builtin_amdgcn_cvt_pk_fp8_f32(o[3].x, o[3].y, w.y, true);
                w2[mm] = w; }
              *(u32x4*)(act + (size_t)u.pm * 262144 + (size_t)(4 * u.pn + wc) * 8192 + (wr * 64 + fr + ai * HALF + (2 * mp + (fq & 1)) * 16) * 32 + 8 * (fq & 2)) = pair_rows16(w2[0], w2[1]); }
    }
};
struct EpiDown {
    static constexpr int PERM = 2; static constexpr bool SIDE = true;
    __device__ __forceinline__ const float* side_ptr0(const Unit& u, int tid) const { return (tid < 256 ? bd : wsc) + (size_t)u.e * 1024 + u.pn * BM + (tid & 255); }
    __device__ __forceinline__ const float* side_ptr1(const Unit& u, int tid) const { return bd; }
    unsigned char* out; const float* bd; const float* wsc;
    template <class AV> __device__ __forceinline__ void operator()(const AV (&acc)[2][2][4][2], const Unit& u, int wr, int wc, int fr, int fq, const LAS float* sd) const {
        const int row0 = u.pm * BM + wr * 64 + fr, cl = wc * 64 + fq * 16, ct = u.pn * BM + cl;
        f32x4 bv[2][2], sv[2][2];
#pragma unroll
        for (int bj = 0; bj < 2; ++bj)
#pragma unroll
            for (int n = 0; n < 2; ++n) { bv[bj][n] = *(const LAS f32x4*)(sd + cl + 8 * bj + 4 * n) * 4.0f; sv[bj][n] = *(const LAS f32x4*)(sd + 256 + cl + 8 * bj + 4 * n); }
#pragma unroll
        for (int ai = 0; ai < 2; ++ai)
#pragma unroll
            for (int m = 0; m < 4; ++m) { unsigned char* rowp = out + (size_t)(row0 + ai * HALF + m * 16) * DM + ct; u32x4 w;
#pragma unroll
                for (int bj = 0; bj < 2; ++bj) { f32x4 v0 = acc[ai][bj][m][0] * sv[bj][0] + bv[bj][0], v1 = acc[ai][bj][m][1] * sv[bj][1] + bv[bj][1];
#pragma unroll
                    for (int j = 0; j < 4; ++j) { v0[j] = __builtin_amdgcn_fmed3f(v0[j], -448.0f, 448.0f); v1[j] = __builtin_amdgcn_fmed3f(v1[j], -448.0f, 448.0f); }
                    unsigned a = __builtin_amdgcn_cvt_pk_fp8_f32(v0[0], v0[1], 0, false); a = __builtin_amdgcn_cvt_pk_fp8_f32(v0[2], v0[3], a, true);
                    unsigned b = __builtin_amdgcn_cvt_pk_fp8_f32(v1[0], v1[1], 0, false); b = __builtin_amdgcn_cvt_pk_fp8_f32(v1[2], v1[3], b, true);
                    if (bj == 0) { w.x = a; w.y = b; } else { w.z = a; w.w = b; } }
                *(u32x4*)rowp = w; }
    }
};
template <bool SECOND> struct EpiGate {
    static constexpr int PERM = 2; static constexpr bool SIDE = true;
    __device__ __forceinline__ const float* side_ptr0(const Unit& u, int tid) const { return wsc + u.pn * BM + (tid & 255); }
    __device__ __forceinline__ const float* side_ptr1(const Unit& u, int tid) const { return wsc; }
    unsigned char* merged; const unsigned char* mg; const float* wsc;
    template <class AV> __device__ __forceinline__ void operator()(const AV (&acc)[2][2][4][2], const Unit& u, int wr, int wc, int fr, int fq, const LAS float* sd) const {
        const int row0 = u.pm * BM + wr * 64 + fr, cl = wc * 64 + fq * 16, ct = u.pn * BM + cl;
        f32x4 sv[2][2];
#pragma unroll
        for (int bj = 0; bj < 2; ++bj)
#pragma unroll
            for (int n = 0; n < 2; ++n) sv[bj][n] = *(const LAS f32x4*)(sd + cl + 8 * bj + 4 * n) * (1.0f / 255.0f);
#pragma unroll
        for (int ai = 0; ai < 2; ++ai) {
            u32x4 z[4], p[4];
#pragma unroll
            for (int m = 0; m < 4; ++m) { const size_t row = (size_t)(row0 + ai * HALF + m * 16);
                z[m] = __builtin_nontemporal_load((const u32x4*)(mg + row * 2048 + (SECOND ? 1024 : 0) + ct));
                if (SECOND) p[m] = *(const u32x4*)(merged + row * DM + ct); }
            asm volatile("" ::: "memory");
#pragma unroll
            for (int m = 0; m < 4; ++m) { const size_t row = (size_t)(row0 + ai * HALF + m * 16); u32x4 w;
#pragma unroll
                for (int bj = 0; bj < 2; ++bj) { const unsigned zx = bj ? z[m].z : z[m].x, zy = bj ? z[m].w : z[m].y; float o[8]; const f32x4 a0 = acc[ai][bj][m][0] * sv[bj][0], a1 = acc[ai][bj][m][1] * sv[bj][1];
                    o[0] = (float)(zx & 255u) * a0[0]; o[1] = (float)((zx >> 8) & 255u) * a0[1]; o[2] = (float)((zx >> 16) & 255u) * a0[2]; o[3] = (float)(zx >> 24) * a0[3];
                    o[4] = (float)(zy & 255u) * a1[0]; o[5] = (float)((zy >> 8) & 255u) * a1[1]; o[6] = (float)((zy >> 16) & 255u) * a1[2]; o[7] = (float)(zy >> 24) * a1[3];
                    if (SECOND) { const unsigned px = bj ? p[m].z : p[m].x, py = bj ? p[m].w : p[m].y;
                        const f32x2 q0 = __builtin_amdgcn_cvt_pk_f32_fp8(px, false), q1 = __builtin_amdgcn_cvt_pk_f32_fp8(px, true), q2 = __builtin_amdgcn_cvt_pk_f32_fp8(py, false), q3 = __builtin_amdgcn_cvt_pk_f32_fp8(py, true);
                        o[0] += q0.x; o[1] += q0.y; o[2] += q1.x; o[3] += q1.y; o[4] += q2.x; o[5] += q2.y; o[6] += q3.x; o[7] += q3.y; }
                    unsigned a = __builtin_amdgcn_cvt_pk_fp8_f32(o[0], o[1], 0, false); a = __builtin_amdgcn_cvt_pk_fp8_f32(o[2], o[3], a, true);
                    unsigned b = __builtin_amdgcn_cvt_pk_fp8_f32(o[4], o[5], 0, false); b = __builtin_amdgcn_cvt_pk_fp8_f32(o[6], o[7], b, true);
                    if (bj == 0) { w.x = a; w.y = b; } else { w.z = a; w.w = b; } }
                *(u32x4*)(merged + row * DM + ct) = w; }
            asm volatile("" ::: "memory");
        }
    }
};
struct EpiMix {
    static constexpr bool PERM = true, SIDE = true;
    __device__ __forceinline__ const float* side_ptr0(const Unit& u, int tid) const { return wsc + u.pn * BM + (tid & 255); }
    __device__ __forceinline__ const float* side_ptr1(const Unit& u, int tid) const { return wsc; }
    bf16_t* out; const float* wsc;
    template <class AV> __device__ __forceinline__ void operator()(const AV (&acc)[2][2][4][2], const Unit& u, int wr, int wc, int fr, int fq, const LAS float* sd) const {
        const int row0 = u.pm * BM + wr * 64 + fr, ct = u.pn * BM + wc * 32 + 8 * fq;
        f32x4 sv[2][2];
#pragma unroll
        for (int bj = 0; bj < 2; ++bj)
#pragma unroll
            for (int n = 0; n < 2; ++n) sv[bj][n] = *(const LAS f32x4*)(sd + bj * HALF + wc * 32 + 8 * fq + 4 * n) * (1.0f / 16.0f);
#pragma unroll
        for (int ai = 0; ai < 2; ++ai)
#pragma unroll
            for (int m = 0; m < 4; ++m) { bf16_t* rowp = out + (size_t)(row0 + ai * HALF + m * 16) * DM + ct;
#pragma unroll
                for (int bj = 0; bj < 2; ++bj) { const f32x4 v0 = acc[ai][bj][m][0] * sv[bj][0], v1 = acc[ai][bj][m][1] * sv[bj][1];
                    u32x4 w; w.x = pk2(v0[0], v0[1]); w.y = pk2(v0[2], v0[3]); w.z = pk2(v1[0], v1[1]); w.w = pk2(v1[2], v1[3]);
                    *(u32x4*)(rowp + bj * HALF) = w; } }
    }
};
}

struct Frame {
    LAS unsigned char* lds;
    unsigned char* ws; unsigned* ctl;
    int tid, lane, wave, G, bid;
    const float* in[24]; float* out;
};

__device__ __forceinline__ void tr_item(const float* W, size_t ldw, int k0, size_t nsrc0, int nvalid, bf16_t* dst, size_t ldt, LAS float* scr, int lane) {
#pragma unroll 8
    for (int i = 0; i < 32; ++i) { const int kk = 2 * i + (lane >> 5), j = lane & 31; float v = 0.f; if (j < nvalid) v = W[(size_t)(k0 + kk) * ldw + nsrc0 + j]; scr[kk * 33 + j] = v; }
    LDS_WAIT(); asm volatile("" ::: "memory");
    const int c = lane & 7;
#pragma unroll
    for (int j = 0; j < 4; ++j) { const int n = (lane >> 3) + 8 * j; const LAS float* s = scr + (8 * c) * 33 + n;
        u32x4 o; o.x = pk2(s[0 * 33], s[1 * 33]); o.y = pk2(s[2 * 33], s[3 * 33]); o.z = pk2(s[4 * 33], s[5 * 33]); o.w = pk2(s[6 * 33], s[7 * 33]);
        *(u32x4*)(dst + (size_t)n * ldt + 8 * c) = o; }
    LDS_WAIT(); asm volatile("" ::: "memory");
}
template <bool FP8, int KROWS = 1024>
__device__ __forceinline__ void quant_block_item(const float* W, size_t ldw, size_t nsrc, int nvalid, signed char* dst, float* scale_out, LAS unsigned char* lds, int tid) {
    LAS unsigned char* slab = lds;
    LAS float* pmax = (LAS float*)(lds + 132352);
    LAS float* cinv = (LAS float*)(lds + 132352 + 2048);
    LAS unsigned* tt = (LAS unsigned*)(lds + 134656);
    const int c4 = tid & 15, r4 = tid >> 4;
    const bool cv = 4 * c4 < nvalid;
    const float* wp = W + nsrc + (cv ? 4 * c4 : 0);
    f32x4 am = {0.f, 0.f, 0.f, 0.f};
    constexpr int QLB = 16;
#pragma nounroll
    for (int sb = 0; sb < KROWS / 32; sb += QLB) { f32x4 vv[QLB];
#pragma unroll
        for (int u = 0; u < QLB; ++u) vv[u] = __builtin_nontemporal_load((const f32x4*)(wp + (size_t)(32 * (sb + u) + r4) * ldw));
#pragma unroll
        for (int u = 0; u < QLB; ++u) { f32x4 v = vv[u]; if (!cv) v = (f32x4){0.f, 0.f, 0.f, 0.f}; const int st = sb + u;
            am[0] = fmaxf(am[0], fabsf(v[0])); am[1] = fmaxf(am[1], fabsf(v[1])); am[2] = fmaxf(am[2], fabsf(v[2])); am[3] = fmaxf(am[3], fabsf(v[3]));
            u32x2 pw; pw.x = pk2(v[0], v[1]); pw.y = pk2(v[2], v[3]); *(LAS u32x2*)(slab + (32 * st + r4) * 128 + c4 * 8) = pw; } }
#pragma unroll
    for (int k = 0; k < 4; ++k) { am[k] = fmaxf(am[k], __shfl_xor(am[k], 16)); am[k] = fmaxf(am[k], __shfl_xor(am[k], 32)); }
    if ((tid & 63) < 16) *(LAS f32x4*)(pmax + (tid >> 6) * 64 + 4 * c4) = am;
    __syncthreads();
    if (tid < 64) { float a = 0.f;
#pragma unroll
        for (int w = 0; w < 8; ++w) a = fmaxf(a, pmax[w * 64 + tid]);
        if (FP8) { const int ex = (int)((__float_as_uint(a) >> 23) & 255u) - 127 - 7;
            cinv[tid] = a > 0.f ? __uint_as_float((unsigned)(127 - ex) << 23) : 0.f; scale_out[tid] = a > 0.f ? __uint_as_float((unsigned)(127 + ex) << 23) : 1.0f; }
        else { cinv[tid] = a > 0.f ? 127.0f / a : 0.f; scale_out[tid] = a > 0.f ? a * (1.0f / 127.0f) : 1.0f; } }
    __syncthreads();
    const f32x4 iv = *(const LAS f32x4*)(cinv + 4 * c4);
    for (int qd = 0; qd < KROWS / 256; ++qd) {
#pragma unroll
        for (int s2 = 0; s2 < 2; ++s2) {
            f32x4 v[4];
#pragma unroll
            for (int i = 0; i < 4; ++i) { const u32x2 pw = *(const LAS u32x2*)(slab + (256 * qd + 128 * s2 + 4 * r4 + i) * 128 + c4 * 8); v[i] = (f32x4){bflo(pw.x), bfhi(pw.x), bflo(pw.y), bfhi(pw.y)}; }
#pragma unroll
            for (int c = 0; c < 4; ++c) { unsigned wq;
                if (FP8) { wq = __builtin_amdgcn_cvt_pk_fp8_f32(v[0][c] * iv[c], v[1][c] * iv[c], 0, false); wq = __builtin_amdgcn_cvt_pk_fp8_f32(v[2][c] * iv[c], v[3][c] * iv[c], wq, true); }
                else wq = pk4(rintf(v[0][c] * iv[c]), rintf(v[1][c] * iv[c]), rintf(v[2][c] * iv[c]), rintf(v[3][c] * iv[c]));
                tt[(4 * c4 + c) * 65 + 32 * s2 + r4] = wq; }
        }
        __syncthreads();
#pragma unroll
        for (int it = 0; it < 8; ++it) { const int n = 8 * it + (tid >> 6), kd = tid & 63; *(unsigned*)(dst + (size_t)n * 1024 + 256 * qd + 4 * kd) = tt[n * 65 + kd]; }
        __syncthreads();
    }
}
constexpr int N_EXPERT_ITEMS = 1024 + 512;
__device__ __forceinline__ void expert_quant_item(Frame& F, int it) {
    unsigned char* ws = F.ws;
    if (it < 1024) { const int e = it >> 5, n0 = 64 * (it & 31), pn = n0 >> 8, j = n0 & 255; const int nsrc = j < 128 ? 128 * pn + j : 1024 + 128 * pn + (j - 128);
        quant_block_item<false>(F.in[18] + (size_t)e * 1024 * 2048, 2048, nsrc, 64, (signed char*)(ws + WS_WGU) + ((size_t)e * 2048 + n0) * 1024, (float*)(ws + WS_WSGU) + e * 2048 + n0, F.lds, F.tid); }
    else { const int r2 = it - 1024, e = r2 >> 4, n0 = 64 * (r2 & 15);
        quant_block_item<true>(F.in[20] + (size_t)e * 1024 * 1024, 1024, n0, 64, (signed char*)(ws + WS_WDN) + ((size_t)e * 1024 + n0) * 1024, (float*)(ws + WS_WSDN) + e * 1024 + n0, F.lds, F.tid); }
}
__device__ __forceinline__ void p0_prologue(Frame& F) {
    LAS float* scr = (LAS float*)(F.lds + F.wave * 16384);
    const int gw = F.bid * NWAVES + F.wave, NGW = F.G * NWAVES, lane = F.lane;
    unsigned char* ws = F.ws;
    constexpr int I_C1 = 32 * 4, I_C2 = 2 * 2;
    constexpr int NITEMS = 2 * I_C1 + 2 * I_C2;
    for (int it = F.bid; it < 68 + 48; it += F.G) {
        if (it >= 68) { const int r3 = it - 68, which = r3 >> 4, n0 = 64 * (r3 & 15);
            if (which == 0) quant_block_item<true, 512>(F.in[11], 1024, n0, 64, (signed char*)(ws + WS_WAB) + (size_t)n0 * 1024, (float*)(ws + WS_WSAB) + n0, F.lds, F.tid);
            else if (which == 1) quant_block_item<true, 512>(F.in[12], 1024, n0, 64, (signed char*)(ws + WS_WAB) + (size_t)n0 * 1024 + 512, (float*)(ws + WS_WSAB) + 1024 + n0, F.lds, F.tid);
            else quant_block_item<true, 1024>(F.in[13], 1024, n0, 64, (signed char*)(ws + WS_WOUT) + (size_t)n0 * 1024, (float*)(ws + WS_WSAB) + 2048 + n0, F.lds, F.tid); }
        else { const int n0 = 64 * it; size_t nsrc; int nv = 64;
            if (n0 < 2048) nsrc = n0; else if (n0 < 4096) nsrc = n0 + 24; else if (n0 == 4096) { nsrc = 2048; nv = 24; } else { nsrc = 0; nv = 0; }
            quant_block_item<false>(F.in[1], 4120, nsrc, nv, (signed char*)(ws + WS_WIN) + (size_t)n0 * 1024, (float*)(ws + WS_WSIN) + n0, F.lds, F.tid); }
    }
    for (int it = F.bid; it < 256; it += F.G) { const int kv = it >> 7, n = it & 127; const float* pos = kv ? F.in[8] : F.in[5]; const float* w1 = kv ? F.in[9] : F.in[6];
        float sacc = 0.f;
#pragma unroll
        for (int k = F.tid; k < 2048; k += 512) sacc += pos[k] * w1[(size_t)k * 128 + n];
        sacc = wave_sum(sacc); LAS float* red = (LAS float*)F.lds;
        __syncthreads(); if (lane == 0) red[F.wave] = sacc; __syncthreads();
        if (F.tid == 0) ((float*)(ws + WS_B1))[it] = ((red[0] + red[1]) + (red[2] + red[3])) + ((red[4] + red[5]) + (red[6] + red[7])); }
    __syncthreads();
    for (int it = gw; it < NITEMS; it += NGW) {
        int r = it;
        if (r < 2 * I_C1) { const int kv = r / I_C1, q = r % I_C1, kb = q / 4, nb = q % 4;
            tr_item(kv ? F.in[9] : F.in[6], 128, 64 * kb, 32 * nb, 32, (bf16_t*)(ws + WS_CW1) + ((size_t)kv * 128 + 32 * nb) * 2048 + 64 * kb, 2048, scr, lane); continue; }
        r -= 2 * I_C1;
        { const int kv = r / I_C2, q = r % I_C2, kb = q / 2, nb = q % 2;
            tr_item(kv ? F.in[10] : F.in[7], 64, 64 * kb, 32 * nb, 32, (bf16_t*)(ws + WS_CW2) + ((size_t)kv * 64 + 32 * nb) * 128 + 64 * kb, 128, scr, lane); }
    }
    constexpr int P0_R = 4;
    for (int m0 = gw; m0 < T; m0 += P0_R * NGW) {
        f32x4 v[P0_R][4];
#pragma unroll
        for (int r = 0; r < P0_R; ++r) { int m = m0 + r * NGW; m = m < T ? m : T - 1; const f32x4* xr = (const f32x4*)(F.in[0] + (size_t)m * DM) + lane;
#pragma unroll
            for (int j = 0; j < 4; ++j) v[r][j] = __builtin_nontemporal_load(xr + 64 * j); }
#pragma unroll
        for (int r = 0; r < P0_R; ++r) { int m = m0 + r * NGW; m = m < T ? m : T - 1;
            unsigned* o = (unsigned*)(ws + WS_XB + (size_t)m * DM) + lane; float amax = 0.f;
#pragma unroll
            for (int j = 0; j < 4; ++j) amax = fmaxf(fmaxf(amax, fmaxf(fabsf(v[r][j][0]), fabsf(v[r][j][1]))), fmaxf(fabsf(v[r][j][2]), fabsf(v[r][j][3])));
            amax = wave_max_nonneg(amax);
            const float inv = amax > 0.f ? 127.0f / amax : 0.f;
            if (lane == 0) ((float*)(ws + WS_XS))[m] = amax > 0.f ? amax * (1.0f / 127.0f) : 1.0f;
#pragma unroll
            for (int j = 0; j < 4; ++j) o[64 * j] = pk4(rintf(v[r][j][0] * inv), rintf(v[r][j][1] * inv), rintf(v[r][j][2] * inv), rintf(v[r][j][3] * inv)); }
    }
    for (int n = F.bid * 512 + F.tid; n < NPROJ; n += F.G * 512) {
        float v = 0.f; if (n < 2048) v = F.in[2][n]; else if (n < 4096) v = F.in[2][n + 24]; else if (n < 4120) v = F.in[2][n - 4096 + 2048];
        ((float*)(ws + WS_BINP))[n] = v; }
}

__device__ __forceinline__ int crow(int r, int hi) { return (r & 3) + 8 * (r >> 2) + 4 * hi; }
__device__ __forceinline__ float half_other_max(float v) { auto rr = __builtin_amdgcn_permlane32_swap(__float_as_uint(v), __float_as_uint(v), false, false); return fmaxf(__uint_as_float(rr[0]), __uint_as_float(rr[1])); }
__device__ __forceinline__ float half_other_sum(float v) { auto rr = __builtin_amdgcn_permlane32_swap(__float_as_uint(v), __float_as_uint(v), false, false); return __uint_as_float(rr[0]) + __uint_as_float(rr[1]); }

constexpr int AL_K = 0, AL_V = 16384, AL_TAB = 32768  , AL_SEL = 40960  , AL_IMP = 41216  ,
              AL_IMPS = 75008  , AL_OST = 83456  , AL_END = 116224;
constexpr int AL_XB = AL_END  , AL_NEG = AL_XB + 8192  ;
static_assert(AL_NEG + 1024 <= LDSCTL_OFF, "attention lds");

__device__ __forceinline__ void tile_load(const bf16_t* kbase, const bf16_t* vbase, size_t pitch, int tid, u32x4& kr, u32x4& vr) {
    const int r = tid >> 3, c = tid & 7;
    kr = *(const u32x4*)(kbase + (size_t)r * pitch + c * 8); vr = *(const u32x4*)(vbase + (size_t)r * pitch + c * 8);
}
__device__ __forceinline__ void tile_store(LAS unsigned char* kbuf, LAS unsigned char* vbuf, int tid, const u32x4& kr, const u32x4& vr) {
    const int r = tid >> 3, c = tid & 7;
    *(LAS u32x4*)(kbuf + r * 128 + ((c ^ ((r >> 1) & 7)) << 4)) = kr;
    *(LAS u32x4*)(vbuf + r * 128 + ((c ^ (((r >> 1) & 1) << 2)) << 4)) = vr;
}
__device__ __forceinline__ void qk_tile(const LAS unsigned char* kbuf, const bf16x8 (&qf)[4], int r32, int hi, f32x16& p0, f32x16& p1) {
    const f32x16 z = {0.f, 0.f, 0.f, 0.f, 0.f, 0.f, 0.f, 0.f, 0.f, 0.f, 0.f, 0.f, 0.f, 0.f, 0.f, 0.f};
    p0 = z; p1 = z;
    const int sw0 = (r32 >> 1) & 7;
#pragma unroll
    for (int d0 = 0; d0 < 4; ++d0) {
        const int ch = ((2 * d0 + hi) ^ sw0) << 4;
        const bf16x8 a0 = *(const LAS bf16x8*)(kbuf + r32 * 128 + ch);
        const bf16x8 a1 = *(const LAS bf16x8*)(kbuf + (32 + r32) * 128 + ch);
        p0 = __builtin_amdgcn_mfma_f32_32x32x16_bf16(a0, qf[d0], p0, 0, 0, 0);
        p1 = __builtin_amdgcn_mfma_f32_32x32x16_bf16(a1, qf[d0], p1, 0, 0, 0);
    }
}
__device__ __forceinline__ void qk_tile_acc(const LAS unsigned char* kbuf, const bf16x8 (&qf)[4], int r32, int hi, f32x16& p0, f32x16& p1) {
    const int sw0 = (r32 >> 1) & 7;
#pragma unroll
    for (int d0 = 0; d0 < 4; ++d0) {
        const int ch = ((2 * d0 + hi) ^ sw0) << 4;
        const bf16x8 a0 = *(const LAS bf16x8*)(kbuf + r32 * 128 + ch);
        const bf16x8 a1 = *(const LAS bf16x8*)(kbuf + (32 + r32) * 128 + ch);
        p0 = __builtin_amdgcn_mfma_f32_32x32x16_bf16(a0, qf[d0], p0, 0, 0, 0);
        p1 = __builtin_amdgcn_mfma_f32_32x32x16_bf16(a1, qf[d0], p1, 0, 0, 0);
    }
}
__device__ __forceinline__ s16x4 vtr(const LAS unsigned char* p) { typedef short v4i16_t __attribute__((ext_vector_type(4))); return __builtin_bit_cast(s16x4, __builtin_amdgcn_ds_read_tr16_b64_v4i16((LAS v4i16_t*)p)); }
__device__ __forceinline__ bf16x8 pack8(const f32x16& p, int s) {
    u32x4 w; w.x = pk2(p[8 * s + 0], p[8 * s + 1]); w.y = pk2(p[8 * s + 2], p[8 * s + 3]); w.z = pk2(p[8 * s + 4], p[8 * s + 5]); w.w = pk2(p[8 * s + 6], p[8 * s + 7]);
    return __builtin_bit_cast(bf16x8, w);
}
__device__ __forceinline__ void pv_tile(const LAS unsigned char* vbuf, const f32x16& p0, const f32x16& p1, f32x16& o0, f32x16& o1, int lane) {
    const int hi = lane >> 5, dsub = (lane >> 4) & 1, q = (lane & 15) >> 2, p = lane & 3;
    const int swz = ((q >> 1) & 1) << 2;
    const LAS unsigned char* vb = vbuf + (4 * hi + q) * 128 + 8 * (p & 1);
    const int c0 = ((2 * dsub + (p >> 1)) ^ swz) << 4, c1 = ((4 + 2 * dsub + (p >> 1)) ^ swz) << 4;
#pragma unroll
    for (int blk = 0; blk < 2; ++blk)
#pragma unroll
        for (int s = 0; s < 2; ++s) {
            const bf16x8 pf = pack8(blk ? p1 : p0, s);
            const int rowoff = (32 * blk + 16 * s) * 128;
            const s16x4 lo0 = vtr(vb + rowoff + c0), hi0 = vtr(vb + rowoff + 8 * 128 + c0);
            const s16x4 lo1 = vtr(vb + rowoff + c1), hi1 = vtr(vb + rowoff + 8 * 128 + c1);
            const bf16x8 v0 = __builtin_shufflevector(lo0, hi0, 0, 1, 2, 3, 4, 5, 6, 7), v1 = __builtin_shufflevector(lo1, hi1, 0, 1, 2, 3, 4, 5, 6, 7);
            o0 = __builtin_amdgcn_mfma_f32_32x32x16_bf16(v0, pf, o0, 0, 0, 0);
            o1 = __builtin_amdgcn_mfma_f32_32x32x16_bf16(v1, pf, o1, 0, 0, 0);
        }
}
template <bool SIMPLE>
__device__ __forceinline__ void softmax_tile(f32x16& p0, f32x16& p1, int base_rel, unsigned win, bool lane_on, const LAS float* tab, float bfar,
                                             float& m, float& l, f32x16& o0, f32x16& o1) {
    const float NEG = -INFINITY;
    if (SIMPLE) {
        const float lb = lane_on ? bfar : NEG;
#pragma unroll
        for (int r = 0; r < 16; ++r) { p0[r] += lb; p1[r] += lb; }
    } else {
#pragma unroll
        for (int blk = 0; blk < 2; ++blk)
#pragma unroll
            for (int r = 0; r < 16; ++r) {
                const float pv = blk ? p1[r] : p0[r];
                const int rel = base_rel - (32 * blk + (r & 3) + 8 * (r >> 2));
                const float bias = tab[min((unsigned)rel, 127u)];
                const bool ok = ((unsigned)rel < win) && lane_on;
                const float sv = ok ? pv + bias : NEG;
                if (blk) p1[r] = sv; else p0[r] = sv;
            }
    }
    float m0 = fmaxf(p0[0], p1[0]), m1 = fmaxf(p0[1], p1[1]), m2 = fmaxf(p0[2], p1[2]), m3 = fmaxf(p0[3], p1[3]);
#pragma unroll
    for (int r = 4; r < 16; r += 4) { m0 = fmaxf(m0, fmaxf(p0[r], p1[r])); m1 = fmaxf(m1, fmaxf(p0[r + 1], p1[r + 1])); m2 = fmaxf(m2, fmaxf(p0[r + 2], p1[r + 2])); m3 = fmaxf(m3, fmaxf(p0[r + 3], p1[r + 3])); }
    const float mx = half_other_max(fmaxf(fmaxf(m0, m1), fmaxf(m2, m3)));
    const float mn = fmaxf(m, mx), alpha = __builtin_amdgcn_exp2f(m - mn);
    m = mn;
    float s0 = 0.f, s1 = 0.f, s2 = 0.f, s3 = 0.f;
#pragma unroll
    for (int r = 0; r < 16; r += 2) { f32x2 a = {p0[r], p0[r + 1]}, b = {p1[r], p1[r + 1]}; const f32x2 mn2 = {mn, mn}; a = a - mn2; b = b - mn2;
        p0[r] = __builtin_amdgcn_exp2f(a.x); p0[r + 1] = __builtin_amdgcn_exp2f(a.y); p1[r] = __builtin_amdgcn_exp2f(b.x); p1[r + 1] = __builtin_amdgcn_exp2f(b.y);
        s0 += p0[r]; s1 += p0[r + 1]; s2 += p1[r]; s3 += p1[r + 1]; }
    l = l * alpha + ((s0 + s1) + (s2 + s3));
#pragma unroll
    for (int r = 0; r < 16; ++r) { o0[r] *= alpha; o1[r] *= alpha; }
}
__device__ __forceinline__ void build_bias_tab(Frame& F) {
    LAS float* tab = (LAS float*)(F.lds + AL_TAB);
#pragma unroll
    for (int i = F.tid; i < 16 * 128; i += 512) { const int h = i >> 7, rel = i & 127; int bk;
        if (rel < 16) bk = rel; else { bk = 16 + (rel >= 19) + (rel >= 21) + (rel >= 24) + (rel >= 27) + (rel >= 31) + (rel >= 35) + (rel >= 40) + (rel >= 46)
                + (rel >= 52) + (rel >= 59) + (rel >= 67) + (rel >= 77) + (rel >= 87) + (rel >= 99) + (rel >= 113); }
        tab[i] = F.in[3][bk * 16 + h] * LOG2E; }
}
__device__ __forceinline__ void build_bias_tab_ext(Frame& F) {
    LAS float* tab = (LAS float*)(F.lds + AL_TAB);
#pragma unroll
    for (int i = F.tid; i < 8 * 256; i += 512) { const int h = i >> 8, rel = (i & 255) - 64; float v = -INFINITY;
        if (rel >= 0 && rel < 128) { int bk;
            if (rel < 16) bk = rel; else { bk = 16 + (rel >= 19) + (rel >= 21) + (rel >= 24) + (rel >= 27) + (rel >= 31) + (rel >= 35) + (rel >= 40) + (rel >= 46)
                    + (rel >= 52) + (rel >= 59) + (rel >= 67) + (rel >= 77) + (rel >= 87) + (rel >= 99) + (rel >= 113); }
            v = F.in[3][bk * 16 + h] * LOG2E; }
        tab[i] = v; }
}
__device__ __forceinline__ void build_bias_tab_extB(Frame& F) {
    LAS float* tab = (LAS float*)(F.lds + AL_XB);
#pragma unroll
    for (int i = F.tid; i < 8 * 256; i += 512) { const int h = 8 + (i >> 8), rel = (i & 255) - 64; float v = -INFINITY;
        if (rel >= 0) { const int rc = rel < 127 ? rel : 127; int bk;
            if (rc < 16) bk = rc; else { bk = 16 + (rc >= 19) + (rc >= 21) + (rc >= 24) + (rc >= 27) + (rc >= 31) + (rc >= 35) + (rc >= 40) + (rc >= 46)
                    + (rc >= 52) + (rc >= 59) + (rc >= 67) + (rc >= 77) + (rc >= 87) + (rc >= 99) + (rc >= 113); }
            v = F.in[3][bk * 16 + h] * LOG2E; }
        tab[i] = v; }
    if (F.tid < 256) ((LAS float*)(F.lds + AL_NEG))[F.tid] = -INFINITY;
}
__device__ __forceinline__ void softmax_tail(f32x16& p0, f32x16& p1, float& m, float& l, f32x16& o0, f32x16& o1) {
    float m0 = fmaxf(p0[0], p1[0]), m1 = fmaxf(p0[1], p1[1]), m2 = fmaxf(p0[2], p1[2]), m3 = fmaxf(p0[3], p1[3]);
#pragma unroll
    for (int r = 4; r < 16; r += 4) { m0 = fmaxf(m0, fmaxf(p0[r], p1[r])); m1 = fmaxf(m1, fmaxf(p0[r + 1], p1[r + 1])); m2 = fmaxf(m2, fmaxf(p0[r + 2], p1[r + 2])); m3 = fmaxf(m3, fmaxf(p0[r + 3], p1[r + 3])); }
    const float mx = half_other_max(fmaxf(fmaxf(m0, m1), fmaxf(m2, m3)));
    const float mn = fmaxf(m, mx), alpha = __builtin_amdgcn_exp2f(m - mn);
    m = mn;
    float s0 = 0.f, s1 = 0.f, s2 = 0.f, s3 = 0.f;
#pragma unroll
    for (int r = 0; r < 16; r += 2) { f32x2 a = {p0[r], p0[r + 1]}, b = {p1[r], p1[r + 1]}; const f32x2 mn2 = {mn, mn}; a = a - mn2; b = b - mn2;
        p0[r] = __builtin_amdgcn_exp2f(a.x); p0[r + 1] = __builtin_amdgcn_exp2f(a.y); p1[r] = __builtin_amdgcn_exp2f(b.x); p1[r + 1] = __builtin_amdgcn_exp2f(b.y);
        s0 += p0[r]; s1 += p0[r + 1]; s2 += p1[r]; s3 += p1[r + 1]; }
    l = l * alpha + ((s0 + s1) + (s2 + s3));
#pragma unroll
    for (int r = 0; r < 16; ++r) { o0[r] *= alpha; o1[r] *= alpha; }
}
__device__ __forceinline__ void softmax_tile_ext(f32x16& p0, f32x16& p1, const LAS float* tb, float& m, float& l, f32x16& o0, f32x16& o1) {
#pragma unroll
    for (int r = 0; r < 16; ++r) { const int c = (r & 3) + 8 * (r >> 2); p0[r] += tb[-c]; p1[r] += tb[-(32 + c)]; }
    softmax_tail(p0, p1, m, l, o0, o1);
}
__device__ __forceinline__ void softmax_tile_edge(f32x16& p0, f32x16& p1, int base_rel, int win, float bfar, float& m, float& l, f32x16& o0, f32x16& o1) {
#pragma unroll
    for (int r = 0; r < 16; ++r) { const int c = (r & 3) + 8 * (r >> 2);
        p0[r] += base_rel < win + c ? bfar : -INFINITY; p1[r] += base_rel < win + 32 + c ? bfar : -INFINITY; }
    softmax_tail(p0, p1, m, l, o0, o1);
}
__device__ __forceinline__ void branch_fold(const f32x16& o0, const f32x16& o1, float l, float gate, f32x16& oc0, f32x16& oc1) {
    const float lt = half_other_sum(l); const float sc = lt > 0.f ? gate / lt : 0.f;
#pragma unroll
    for (int r = 0; r < 16; ++r) { oc0[r] += o0[r] * sc; oc1[r] += o1[r] * sc; }
}
__device__ __forceinline__ void store_o8(LAS unsigned char* ost, const f32x16& oc0, const f32x16& oc1, unsigned char* dst  , int lane) {
    const int q = lane & 31, hi = lane >> 5;
#pragma unroll
    for (int dblk = 0; dblk < 2; ++dblk)
#pragma unroll
        for (int g4 = 0; g4 < 4; ++g4) { const f32x16& o = dblk ? oc1 : oc0; unsigned w = __builtin_amdgcn_cvt_pk_fp8_f32(16.0f * o[4 * g4 + 0], 16.0f * o[4 * g4 + 1], 0, false);
            w = __builtin_amdgcn_cvt_pk_fp8_f32(16.0f * o[4 * g4 + 2], 16.0f * o[4 * g4 + 3], w, true);
            *(LAS unsigned*)(ost + q * 64 + 32 * dblk + 8 * g4 + 4 * hi) = w; }
    LDS_WAIT(); asm volatile("" ::: "memory");
#pragma unroll
    for (int it = 0; it < 2; ++it) { const int row = it * 16 + (lane >> 2), ch = lane & 3; const u32x4 v = *(const LAS u32x4*)(ost + row * 64 + ch * 16);
        *(u32x4*)(dst + (size_t)row * 1024 + ch * 16) = v; }
    LDS_WAIT(); asm volatile("" ::: "memory");
}
__device__ __forceinline__ void store_o(LAS unsigned char* ost, const f32x16& oc0, const f32x16& oc1, bf16_t* dst  , int lane) {
    const int q = lane & 31, hi = lane >> 5;
#pragma unroll
    for (int dblk = 0; dblk < 2; ++dblk)
#pragma unroll
        for (int g4 = 0; g4 < 4; ++g4) { const f32x16& o = dblk ? oc1 : oc0; u32x2 w; w.x = pk2(o[4 * g4 + 0], o[4 * g4 + 1]); w.y = pk2(o[4 * g4 + 2], o[4 * g4 + 3]);
            *(LAS u32x2*)(ost + q * 128 + (32 * dblk + 8 * g4 + 4 * hi) * 2) = w; }
    LDS_WAIT(); asm volatile("" ::: "memory");
#pragma unroll
    for (int it = 0; it < 4; ++it) { const int row = it * 8 + (lane >> 3), ch = lane & 7; const u32x4 v = *(const LAS u32x4*)(ost + row * 128 + ch * 16);
        *(u32x4*)(dst + (size_t)row * 1024 + ch * 8) = v; }
    LDS_WAIT(); asm volatile("" ::: "memory");
}
__device__ __forceinline__ void attn_unit_decode(int U, int& b, int& g, int& i) {
    const int rr = U >> 8, p = (U & 255) >> 2, s = U & 3; b = p >> 1; g = p & 1; i = (rr & 1) ? 4 * rr + 3 - s : 4 * rr + s;
}

__device__ __forceinline__ void attnA_unit(Frame& F, int U) {
    int b, g, i; attn_unit_decode(U, b, g, i);
    const int tid = F.tid, lane = F.lane, w = F.wave, q = lane & 31, hi = lane >> 5, hq = w >> 1;
    const int t0 = 64 * i, tw0 = t0 + 32 * (w & 1), tq = tw0 + q; const size_t tokb = (size_t)b * SEQ;
    const bf16_t* QA = (const bf16_t*)(F.ws + WS_QA); const bf16_t* KVA = (const bf16_t*)(F.ws + WS_KVA);
    LAS unsigned char* lds = F.lds;
    bf16x8 qf[4];
#pragma unroll
    for (int d0 = 0; d0 < 4; ++d0) qf[d0] = *(const bf16x8*)(QA + (tokb + tq) * 512 + (g * 4 + hq) * 64 + 16 * d0 + 8 * hi);
    const LAS float* tabx = (const LAS float*)(lds + AL_TAB) + (g * 4 + hq) * 256 + 64;
    float m = F.in[4][g * 4 + hq] * LOG2E, l = hi == 0 ? 1.f : 0.f;
    f32x16 o0, o1; { const f32x16 z = {0.f, 0.f, 0.f, 0.f, 0.f, 0.f, 0.f, 0.f, 0.f, 0.f, 0.f, 0.f, 0.f, 0.f, 0.f, 0.f}; o0 = z; o1 = z; }
    const int j0 = i >= 2 ? i - 2 : 0, nt = i - j0 + 1;
    const bf16_t* kg = KVA + tokb * 256 + g * 64; const bf16_t* vg = kg + 128;
    u32x4 kr, vr;
    tile_load(kg + (size_t)(64 * j0) * 256, vg + (size_t)(64 * j0) * 256, 256, tid, kr, vr);
    tile_store(lds + AL_K, lds + AL_V, tid, kr, vr);
    __syncthreads();
    for (int n = 0; n < nt; ++n) {
        const int j = j0 + n, kb = 64 * j;
        if (n + 1 < nt) tile_load(kg + (size_t)(kb + 64) * 256, vg + (size_t)(kb + 64) * 256, 256, tid, kr, vr);
        const LAS unsigned char* kbuf = lds + AL_K + (n & 1) * 8192; const LAS unsigned char* vbuf = lds + AL_V + (n & 1) * 8192;
        const int minrel = tw0 - (kb + 63), maxrel = tw0 + 31 - kb;
        if (maxrel >= 0 && minrel < 128) {
            f32x16 p0, p1; qk_tile(kbuf, qf, q, hi, p0, p1);
            softmax_tile_ext(p0, p1, tabx + (tq - kb - 4 * hi), m, l, o0, o1);
            pv_tile(vbuf, p0, p1, o0, o1, lane);
        }
        if (n + 1 < nt) tile_store(lds + AL_K + ((n + 1) & 1) * 8192, lds + AL_V + ((n + 1) & 1) * 8192, tid, kr, vr);
        __syncthreads();
    }
    f32x16 oc0, oc1; { const f32x16 z = {0.f, 0.f, 0.f, 0.f, 0.f, 0.f, 0.f, 0.f, 0.f, 0.f, 0.f, 0.f, 0.f, 0.f, 0.f, 0.f}; oc0 = z; oc1 = z; }
    branch_fold(o0, o1, l, 1.0f, oc0, oc1);
    store_o8(lds + AL_OST + w * 4096, oc0, oc1, (unsigned char*)(F.ws + WS_Y) + (tokb + tw0) * 1024 + (g * 4 + hq) * 64, lane);
}

__device__ __forceinline__ void nsa_unit(Frame& F, int U) {
    int b, g, i; attn_unit_decode(U, b, g, i);
    const int tid = F.tid, lane = F.lane, w = F.wave, q = lane & 31, hi = lane >> 5, hq = w >> 1;
    const int t0 = 64 * i, tw0 = t0 + 32 * (w & 1), tq = tw0 + q; const size_t tokb = (size_t)b * SEQ;
    const bf16_t* QB = (const bf16_t*)(F.ws + WS_QB);
    const bf16_t* KVS = (const bf16_t*)(F.ws + WS_KVC + 32 * MiB); const bf16_t* KVW = (const bf16_t*)(F.ws + WS_KVC + 64 * MiB);
    const bf16_t* KC = (const bf16_t*)(F.ws + WS_KC) + (size_t)(b * 2 + g) * 128 * 64; const bf16_t* VC = (const bf16_t*)(F.ws + WS_VC) + (size_t)(b * 2 + g) * 128 * 64;
    LAS unsigned char* lds = F.lds;
    const f32x16 z16 = {0.f, 0.f, 0.f, 0.f, 0.f, 0.f, 0.f, 0.f, 0.f, 0.f, 0.f, 0.f, 0.f, 0.f, 0.f, 0.f};
    bf16x8 qf[4];
#pragma unroll
    for (int d0 = 0; d0 < 4; ++d0) qf[d0] = *(const bf16x8*)(QB + (tokb + tq) * 512 + (g * 4 + hq) * 64 + 16 * d0 + 8 * hi);
    const LAS float* tab = (const LAS float*)(lds + AL_TAB) + (8 + g * 4 + hq) * 128;
    const float bfar = tab[127];
    const LAS float* tabx = (const LAS float*)(lds + AL_XB) + (g * 4 + hq) * 256 + 64; const LAS float* tabn = (const LAS float*)(lds + AL_NEG) + 64;
    float gate[3];
    { const bf16_t* ngp = (const bf16_t*)(F.ws + WS_NG) + (tokb + tq) * 32 + (g * 4 + hq) * 3;
#pragma unroll
      for (int k = 0; k < 3; ++k) gate[k] = fsigmoid(__uint_as_float((unsigned)ngp[k] << 16)); }
    f32x16 oc0 = z16, oc1 = z16, o0, o1;
    u32x4 kr, vr, kr0, vr0;
    { const bf16_t* ks0 = KVS + tokb * 256 + g * 64; tile_load(ks0, ks0 + 128, 256, tid, kr0, vr0); }
    const bool two = i >= 16;
    tile_load(KC, VC, 64, tid, kr, vr); tile_store(lds + AL_K, lds + AL_V, tid, kr, vr);
    if (two) { tile_load(KC + 64 * 64, VC + 64 * 64, 64, tid, kr, vr); tile_store(lds + AL_K + 8192, lds + AL_V + 8192, tid, kr, vr); }
    __syncthreads();
    {
        f32x16 pa, pb, pc = z16, pd = z16;
        qk_tile(lds + AL_K, qf, q, hi, pa, pb); if (two) qk_tile(lds + AL_K + 8192, qf, q, hi, pc, pd);
        const int nvalid = tq >= 31 ? ((tq - 31) >> 4) + 1 : 0;
        float mx = -INFINITY;
#pragma unroll
        for (int r = 0; r < 16; ++r) { const int c = crow(r, hi);
            pa[r] = (c < nvalid) ? pa[r] : -INFINITY; pb[r] = (32 + c < nvalid) ? pb[r] : -INFINITY;
            mx = fmaxf(mx, fmaxf(pa[r], pb[r])); }
        if (two) {
#pragma unroll
            for (int r = 0; r < 16; ++r) { const int c = crow(r, hi);
                pc[r] = (64 + c < nvalid) ? pc[r] : -INFINITY; pd[r] = (96 + c < nvalid) ? pd[r] : -INFINITY;
                mx = fmaxf(mx, fmaxf(pc[r], pd[r])); } }
        mx = half_other_max(mx); if (nvalid == 0) mx = 0.f;
        float sum = 0.f;
#pragma unroll
        for (int r = 0; r < 16; ++r) { pa[r] = __builtin_amdgcn_exp2f(pa[r] - mx); pb[r] = __builtin_amdgcn_exp2f(pb[r] - mx); sum += pa[r] + pb[r]; }
        if (two) {
#pragma unroll
            for (int r = 0; r < 16; ++r) { pc[r] = __builtin_amdgcn_exp2f(pc[r] - mx); pd[r] = __builtin_amdgcn_exp2f(pd[r] - mx); sum += pc[r] + pd[r]; } }
        sum = half_other_sum(sum);
        const float inv = nvalid > 0 ? 1.0f / sum : 0.f;
#pragma unroll
        for (int r = 0; r < 16; ++r) { pa[r] *= inv; pb[r] *= inv; pc[r] *= inv; pd[r] *= inv; }
        o0 = z16; o1 = z16;
        pv_tile(lds + AL_V, pa, pb, o0, o1, lane); if (two) pv_tile(lds + AL_V + 8192, pc, pd, o0, o1, lane);
#pragma unroll
        for (int r = 0; r < 16; ++r) { oc0[r] += gate[0] * o0[r]; oc1[r] += gate[0] * o1[r]; }
        if (i >= 8) {
            LAS float* impw = (LAS float*)(lds + AL_IMP) + (hq * 64 + 32 * (w & 1) + q) * 33;
            float yprev = 0.f;
#pragma unroll
            for (int b4 = 0; b4 < 4; ++b4) { const f32x16& pp = b4 == 0 ? pa : b4 == 1 ? pb : b4 == 2 ? pc : pd;
#pragma unroll
                for (int g4 = 0; g4 < 4; ++g4) { const float a0 = pp[4 * g4], a1 = pp[4 * g4 + 1], a2 = pp[4 * g4 + 2], a3 = pp[4 * g4 + 3];
                    auto rr = __builtin_amdgcn_permlane32_swap(__float_as_uint(a3), __float_as_uint(a3), false, false);
                    const float ylo = __uint_as_float(rr[0]), yhi = __uint_as_float(rr[1]);
                    const float prev = hi ? ylo : yprev;
                    impw[8 * b4 + 2 * g4 + hi] = (a0 + a1) + (a2 + 0.5f * a3) + 0.5f * prev;
                    yprev = yhi; } }
        }
    }
    __syncthreads();
    if (i >= 8) {
        const int tok = tid >> 3, sub = tid & 7;
        { const LAS float* ip = (const LAS float*)(lds + AL_IMP) + tok * 33 + 4 * sub; LAS float* isum = (LAS float*)(lds + AL_IMPS) + tok * 33 + 4 * sub;
#pragma unroll
          for (int jj = 0; jj < 4; ++jj) { const int j = 4 * sub + jj; float v = (ip[jj] + ip[64 * 33 + jj]) + (ip[2 * 64 * 33 + jj] + ip[3 * 64 * 33 + jj]);
              if (j == 0 || (j <= i && j > i - 2)) v = 1e30f; if (j > i) v = -1e30f; isum[jj] = v; } }
        __syncthreads();
        { const LAS float* isum = (const LAS float*)(lds + AL_IMPS) + tok * 33; float mine[4]; int rank[4] = {0, 0, 0, 0};
#pragma unroll
          for (int jj = 0; jj < 4; ++jj) mine[jj] = isum[4 * sub + jj];
#pragma unroll 8
          for (int j2 = 0; j2 < 32; ++j2) { const float v2 = isum[j2];
#pragma unroll
              for (int jj = 0; jj < 4; ++jj) rank[jj] += (v2 > mine[jj] || (v2 == mine[jj] && j2 < 4 * sub + jj)) ? 1 : 0; }
          unsigned bits = 0;
#pragma unroll
          for (int jj = 0; jj < 4; ++jj) if (rank[jj] < 8 && (4 * sub + jj) <= i) bits |= 1u << (4 * sub + jj);
          bits |= __shfl_xor(bits, 1); bits |= __shfl_xor(bits, 2); bits |= __shfl_xor(bits, 4);
          if (sub == 0) ((LAS unsigned*)(lds + AL_SEL))[tok] = bits; }
    } else {
        if (tid < 64) ((LAS unsigned*)(lds + AL_SEL))[tid] = (2u << i) - 1u;
    }
    __syncthreads();
    const unsigned selw = ((const LAS unsigned*)(lds + AL_SEL))[32 * (w & 1) + q];
    const int nslc = i + 1, jw0 = i >= 8 ? i - 8 : 0, nwin = i - jw0 + 1, ntile = nslc + nwin;
    const bf16_t* ks = KVS + tokb * 256 + g * 64; const bf16_t* kw = KVW + tokb * 256 + g * 64;
    tile_store(lds + AL_K, lds + AL_V, tid, kr0, vr0);
    __syncthreads();
    float m = -1e30f, l = 0.f; o0 = z16; o1 = z16;
    for (int n = 0; n < ntile; ++n) {
        if (n + 1 < ntile) { const int n1 = n + 1; const bf16_t* src = n1 < nslc ? ks + (size_t)(64 * n1) * 256 : kw + (size_t)(64 * (jw0 + n1 - nslc)) * 256;
            tile_load(src, src + 128, 256, tid, kr, vr); }
        if (n == nslc) { branch_fold(o0, o1, l, gate[1], oc0, oc1); m = -1e30f; l = 0.f; o0 = z16; o1 = z16; }
        const bool is_slc = n < nslc; const int j = is_slc ? n : jw0 + n - nslc, kb = 64 * j;
        const LAS unsigned char* kbuf = lds + AL_K + (n & 1) * 8192; const LAS unsigned char* vbuf = lds + AL_V + (n & 1) * 8192;
        const int minrel = tw0 - (kb + 63), maxrel = tw0 + 31 - kb;
        const unsigned win = is_slc ? 0x7fffffffu : 512u;
        const bool lane_on = is_slc ? ((selw >> j) & 1u) != 0u : true;
        if (maxrel >= 0 && (is_slc || minrel < 512) && __any(lane_on)) {
            f32x16 p0, p1; qk_tile(kbuf, qf, q, hi, p0, p1);
            if (minrel >= 113 && (is_slc || maxrel < 512)) softmax_tile<true>(p0, p1, 0, win, lane_on, tab, bfar, m, l, o0, o1);
            else if (maxrel <= 191) softmax_tile_ext(p0, p1, (lane_on ? tabx : tabn) + (tq - kb - 4 * hi), m, l, o0, o1);
            else if (minrel >= 127 && !is_slc) softmax_tile_edge(p0, p1, tq - kb - 4 * hi, 512, bfar, m, l, o0, o1);
            else softmax_tile<false>(p0, p1, tq - kb - 4 * hi, win, lane_on, tab, bfar, m, l, o0, o1);
            pv_tile(vbuf, p0, p1, o0, o1, lane);
        }
        if (n + 1 < ntile) tile_store(lds + AL_K + ((n + 1) & 1) * 8192, lds + AL_V + ((n + 1) & 1) * 8192, tid, kr, vr);
        __syncthreads();
    }
    branch_fold(o0, o1, l, gate[2], oc0, oc1);
    store_o8(lds + AL_OST + w * 4096, oc0, oc1, (unsigned char*)(F.ws + WS_Y) + (tokb + tw0) * 1024 + 512 + (g * 4 + hq) * 64, lane);
}

constexpr int CL_A = 0  , CL_HID = 69632  ;
__device__ __forceinline__ float gelu_tanh(float x) { const float u = 0.7978845608028654f * (x + 0.044715f * x * x * x); const float t = __builtin_amdgcn_exp2f(2.0f * LOG2E * u); return 0.5f * x * (2.0f - 2.0f * __builtin_amdgcn_rcpf(t + 1.0f)); }
__device__ __forceinline__ void compress_unit(Frame& F, int U) {
    const int b = U >> 4, g = (U >> 3) & 1, kv = (U >> 2) & 1, c0 = 32 * (U & 3);
    const int tid = F.tid, lane = F.lane, w = F.wave; LAS unsigned char* lds = F.lds;
    const bf16_t* src = (const bf16_t*)(F.ws + WS_KVC) + (size_t)b * SEQ * 256 + kv * 128 + g * 64;
    { u32x4 stg[9];
#pragma unroll
      for (int it = 0; it < 9; ++it) { int idx = tid + 512 * it; idx = idx < 528 * 8 ? idx : 528 * 8 - 1; const int t = idx >> 3, c = idx & 7; int tok = 16 * c0 + t; if (tok > SEQ - 1) tok = SEQ - 1;
          stg[it] = *(const u32x4*)(src + (size_t)tok * 256 + c * 8); }
#pragma unroll
      for (int it = 0; it < 9; ++it) { int idx = tid + 512 * it; idx = idx < 528 * 8 ? idx : 528 * 8 - 1; const int t = idx >> 3, c = idx & 7;
          *(LAS u32x4*)(lds + CL_A + t * 128 + ((c ^ ((t >> 4) & 7)) << 4)) = stg[it]; } }
    const bf16_t* w1t = (const bf16_t*)(F.ws + WS_CW1) + ((size_t)kv * 128 + 16 * w + (lane & 15)) * 2048 + 8 * (lane >> 4);
    bf16x8 bq[2][16];
#pragma unroll
    for (int j = 0; j < 16; ++j) bq[0][j] = *(const bf16x8*)(w1t + 32 * j);
    __syncthreads();
    f32x4 acc[2]; acc[0] = (f32x4){0.f, 0.f, 0.f, 0.f}; acc[1] = acc[0];
    const int m = lane & 15, kq = lane >> 4;
#pragma unroll
    for (int bt = 0; bt < 4; ++bt) {
        if (bt < 3) {
#pragma unroll
            for (int j = 0; j < 16; ++j) bq[(bt + 1) & 1][j] = *(const bf16x8*)(w1t + 32 * (16 * (bt + 1) + j)); }
#pragma unroll
        for (int j = 0; j < 16; ++j) { const int st = 16 * bt + j, lt = st >> 1, ch = 4 * (st & 1) + kq;
#pragma unroll
            for (int mt = 0; mt < 2; ++mt) { const int t = 256 * mt + 16 * m + lt;
                const bf16x8 af = *(const LAS bf16x8*)(lds + CL_A + t * 128 + ((ch ^ ((t >> 4) & 7)) << 4));
                acc[mt] = __builtin_amdgcn_mfma_f32_16x16x32_bf16(af, bq[bt & 1][j], acc[mt], 0, 0, 0); } }
    }
    { const float b1 = ((const float*)(F.ws + WS_B1))[kv * 128 + 16 * w + (lane & 15)]; LAS bf16_t* hid = (LAS bf16_t*)(lds + CL_HID);
#pragma unroll
      for (int mt = 0; mt < 2; ++mt)
#pragma unroll
          for (int r = 0; r < 4; ++r) { const float v = gelu_tanh(acc[mt][r] + b1); hid[(16 * mt + 4 * (lane >> 4) + r) * 136 + 16 * w + (lane & 15)] = (bf16_t)(pk2(v, 0.f) & 0xffffu); } }
    __syncthreads();
    { const int mt2 = w >> 2, nt2 = w & 3; const LAS bf16_t* hid = (const LAS bf16_t*)(lds + CL_HID) + (16 * mt2 + (lane & 15)) * 136 + 8 * (lane >> 4);
      bf16_t* dst = (bf16_t*)(F.ws + (kv ? WS_VC : WS_KC)) + (size_t)(b * 2 + g) * 128 * 64;
      f32x4 a2 = (f32x4){0.f, 0.f, 0.f, 0.f};
      const bf16_t* w2t = (const bf16_t*)(F.ws + WS_CW2) + ((size_t)kv * 64 + 16 * nt2 + (lane & 15)) * 128 + 8 * (lane >> 4);
#pragma unroll
      for (int s2 = 0; s2 < 4; ++s2) { const bf16x8 af = *(const LAS bf16x8*)(hid + 32 * s2); const bf16x8 bf = *(const bf16x8*)(w2t + 32 * s2); a2 = __builtin_amdgcn_mfma_f32_16x16x32_bf16(af, bf, a2, 0, 0, 0); }
#pragma unroll
      for (int r = 0; r < 4; ++r) { const int c = c0 + 16 * mt2 + 4 * (lane >> 4) + r; const float v = c < 127 ? a2[r] : 0.f; dst[(size_t)c * 64 + 16 * nt2 + (lane & 15)] = (bf16_t)(pk2(v, 0.f) & 0xffffu); } }
    __syncthreads();
}

constexpr int RT_ASG = 2 * 16 * 2064 + 8 * 2048, RT_HSC = RT_ASG + 4096, RT_LCNT = RT_HSC + 1024, RT_GBASE = RT_LCNT + 128;
constexpr int HB_ROW = 2064, HB_HI = 0, HB_LO = 16 * HB_ROW, RT_RED = 2 * 16 * HB_ROW;
static_assert(RT_RED + 8 * 16 * 32 * 4 <= 131072, "router LDS");
__device__ __forceinline__ void ln1_router_panel(Frame& F, const int pm) {
    LAS unsigned char* lds = F.lds;
    const int lane = F.lane, w = F.wave;
    f32x4 gv[4], bv[4];
#pragma unroll
    for (int j = 0; j < 4; ++j) { gv[j] = *((const f32x4*)F.in[14] + lane + 64 * j); bv[j] = *((const f32x4*)F.in[15] + lane + 64 * j); }
    const float brt = F.in[17][lane & 31];
    bf16x8 Ahi[2][4], Alo[2][4];
#pragma unroll
    for (int mb = 0; mb < 2; ++mb)
#pragma unroll
        for (int ks = 0; ks < 4; ++ks) { const float* wp = F.in[16] + (size_t)(128 * w + 32 * ks + 8 * (lane >> 4)) * 32 + 16 * mb + (lane & 15);
            u32x4 hw, lw; float a[8];
#pragma unroll
            for (int i = 0; i < 8; ++i) a[i] = wp[32 * i];
            hw.x = pk2(a[0], a[1]); hw.y = pk2(a[2], a[3]); hw.z = pk2(a[4], a[5]); hw.w = pk2(a[6], a[7]);
            lw.x = pk2(a[0] - bflo(hw.x), a[1] - bfhi(hw.x)); lw.y = pk2(a[2] - bflo(hw.y), a[3] - bfhi(hw.y)); lw.z = pk2(a[4] - bflo(hw.z), a[5] - bfhi(hw.z)); lw.w = pk2(a[6] - bflo(hw.w), a[7] - bfhi(hw.w));
            Ahi[mb][ks] = __builtin_bit_cast(bf16x8, hw); Alo[mb][ks] = __builtin_bit_cast(bf16x8, lw); }
    bf16_t* H = (bf16_t*)(F.ws + WS_H); int* list = (int*)(F.ws + WS_LIST); int* tokslot = (int*)(F.ws + WS_TOKSLOT); float* tokgate = (float*)(F.ws + WS_TOKGATE);
    unsigned xn[2][4]; float xsn[2]; u32x2 mn[2][4];
#define RT_ISSUE(batch) do { _Pragma("unroll") for (int tt = 0; tt < 2; ++tt) { const int row_ = pm * 256 + 16 * (batch) + 2 * w + tt; \
        const unsigned* xr_ = (const unsigned*)(F.ws + WS_XB + (size_t)row_ * DM) + lane; const u32x2* mr_ = (const u32x2*)((const bf16_t*)F.out + (size_t)row_ * DM) + lane; \
        xsn[tt] = ((const float*)(F.ws + WS_XS))[row_]; \
        _Pragma("unroll") for (int j = 0; j < 4; ++j) { xn[tt][j] = __builtin_nontemporal_load(xr_ + 64 * j); mn[tt][j] = mr_[64 * j]; } } } while (0)
    RT_ISSUE(0);
    if (F.tid < 32) ((LAS unsigned*)(lds + RT_LCNT))[F.tid] = 0u;
#pragma nounroll
    for (int batch = 0; batch < 16; ++batch) {
        float hsc[2];
#pragma unroll
        for (int tt = 0; tt < 2; ++tt) {
            const int row = pm * 256 + 16 * batch + 2 * w + tt;
            f32x4 v[4]; float s = 0.f;
#pragma unroll
            for (int j = 0; j < 4; ++j) { const u32x2 mw = mn[tt][j]; const int xq = (int)xn[tt][j]; const float xa = xsn[tt] * ALPHA;
                const f32x4 xv = {(float)(signed char)(xq), (float)(signed char)(xq >> 8), (float)(signed char)(xq >> 16), (float)(xq >> 24)};
                v[j] = xv * xa + (f32x4){bflo(mw.x), bfhi(mw.x), bflo(mw.y), bfhi(mw.y)}; s += (v[j][0] + v[j][1]) + (v[j][2] + v[j][3]); }
            const float mean = wave_sum(s) * (1.f / DM); float s2 = 0.f;
#pragma unroll
            for (int j = 0; j < 4; ++j) { v[j] = v[j] - mean; s2 += (v[j][0] * v[j][0] + v[j][1] * v[j][1]) + (v[j][2] * v[j][2] + v[j][3] * v[j][3]); }
            const float rstd = 1.f / sqrtf(wave_sum(s2) * (1.f / DM) + LN_EPS);
            u32x2* ho = (u32x2*)(H + (size_t)row * DM) + lane; float amax = 0.f;
            LAS unsigned char* hb = lds + (2 * w + tt) * HB_ROW + 8 * lane;
#pragma unroll
            for (int j = 0; j < 4; ++j) { v[j] = v[j] * rstd * gv[j] + bv[j]; u32x2 wv; wv.x = pk2(v[j][0], v[j][1]); wv.y = pk2(v[j][2], v[j][3]); ho[64 * j] = wv;
                u32x2 lv; lv.x = pk2(v[j][0] - bflo(wv.x), v[j][1] - bfhi(wv.x)); lv.y = pk2(v[j][2] - bflo(wv.y), v[j][3] - bfhi(wv.y));
                *(LAS u32x2*)(hb + HB_HI + 512 * j) = wv; *(LAS u32x2*)(hb + HB_LO + 512 * j) = lv;
                amax = fmaxf(fmaxf(amax, fmaxf(fabsf(v[j][0]), fabsf(v[j][1]))), fmaxf(fabsf(v[j][2]), fabsf(v[j][3]))); }
            amax = wave_max_nonneg(amax);
            hsc[tt] = amax > 0.f ? amax * (1.0f / 127.0f) : 1.0f;
            { const float inv = amax > 0.f ? 127.0f / amax : 0.f;
              unsigned* hq = (unsigned*)(F.ws + WS_HQ + (size_t)row * DM) + lane;
#pragma unroll
              for (int j = 0; j < 4; ++j) hq[64 * j] = pk4(rintf(v[j][0] * inv), rintf(v[j][1] * inv), rintf(v[j][2] * inv), rintf(v[j][3] * inv)); }
        }
        __syncthreads();
        if (batch + 1 < 16) RT_ISSUE(batch + 1);
        { f32x4 acc[2] = {(f32x4){0.f, 0.f, 0.f, 0.f}, (f32x4){0.f, 0.f, 0.f, 0.f}};
          const LAS unsigned char* bp = lds + (lane & 15) * HB_ROW + (128 * w + 8 * (lane >> 4)) * 2;
#pragma unroll
          for (int ks = 0; ks < 4; ++ks) { const bf16x8 bh = *(const LAS bf16x8*)(bp + HB_HI + 64 * ks), bl = *(const LAS bf16x8*)(bp + HB_LO + 64 * ks);
#pragma unroll
              for (int mb = 0; mb < 2; ++mb) { acc[mb] = __builtin_amdgcn_mfma_f32_16x16x32_bf16(Alo[mb][ks], bh, acc[mb], 0, 0, 0); acc[mb] = __builtin_amdgcn_mfma_f32_16x16x32_bf16(Ahi[mb][ks], bl, acc[mb], 0, 0, 0);
                  acc[mb] = __builtin_amdgcn_mfma_f32_16x16x32_bf16(Ahi[mb][ks], bh, acc[mb], 0, 0, 0); } }
#pragma unroll
          for (int mb = 0; mb < 2; ++mb) *(LAS f32x4*)(lds + RT_RED + w * 2048 + (lane & 15) * 128 + (16 * mb + 4 * (lane >> 4)) * 4) = acc[mb]; }
        __syncthreads();
        float logit = brt;
#pragma unroll
        for (int w2 = 0; w2 < 8; ++w2) logit += *(const LAS float*)(lds + RT_RED + w2 * 2048 + (2 * w) * 128 + lane * 4);
        const int e_me = lane & 31; const bool upper = lane >= 32; int rank = 0;
#pragma unroll
        for (int e2 = 0; e2 < 32; ++e2) { const float va = __uint_as_float((unsigned)__builtin_amdgcn_readlane((int)__float_as_uint(logit), e2)), vb = __uint_as_float((unsigned)__builtin_amdgcn_readlane((int)__float_as_uint(logit), 32 + e2));
            const float v2 = upper ? vb : va; rank += (v2 > logit || (v2 == logit && e2 < e_me)) ? 1 : 0; }
        float tv[2][4]; int te[2][4];
#pragma unroll
        for (int k = 0; k < 4; ++k) { const unsigned long long mk = __ballot(rank == k);
            const int sa = __builtin_amdgcn_readfirstlane((int)__ffs((int)(unsigned)(mk & 0xffffffffull)) - 1), sb = __builtin_amdgcn_readfirstlane((int)__ffs((int)(unsigned)(mk >> 32)) - 1);
            tv[0][k] = __uint_as_float((unsigned)__builtin_amdgcn_readlane((int)__float_as_uint(logit), sa)); te[0][k] = sa;
            tv[1][k] = __uint_as_float((unsigned)__builtin_amdgcn_readlane((int)__float_as_uint(logit), 32 + sb)); te[1][k] = sb; }
        float ex[2][4], es[2] = {0.f, 0.f};
#pragma unroll
        for (int tt = 0; tt < 2; ++tt)
#pragma unroll
            for (int k = 0; k < 4; ++k) { ex[tt][k] = __builtin_amdgcn_exp2f((tv[tt][k] - tv[tt][0]) * LOG2E); es[tt] += ex[tt][k]; }
        if ((lane & 31) < 4) {
            const int k = lane & 3, tt = lane >> 5, rl = 16 * batch + 2 * w + tt, row = pm * 256 + rl;
            const int ea = k == 0 ? te[0][0] : k == 1 ? te[0][1] : k == 2 ? te[0][2] : te[0][3], eb = k == 0 ? te[1][0] : k == 1 ? te[1][1] : k == 2 ? te[1][2] : te[1][3];
            const float xa = k == 0 ? ex[0][0] : k == 1 ? ex[0][1] : k == 2 ? ex[0][2] : ex[0][3], xb = k == 0 ? ex[1][0] : k == 1 ? ex[1][1] : k == 2 ? ex[1][2] : ex[1][3];
            const int e = tt ? eb : ea; const float gt = (tt ? xb : xa) / (tt ? es[1] : es[0]);
            const unsigned ls = __hip_atomic_fetch_add((LAS unsigned*)(lds + RT_LCNT) + e, 1u, __ATOMIC_RELAXED, __HIP_MEMORY_SCOPE_WORKGROUP);
            ((LAS int*)(lds + RT_ASG))[rl * 4 + k] = (e << 16) | (int)ls;
            if (k == 0) ((LAS float*)(lds + RT_HSC))[rl] = tt ? hsc[1] : hsc[0];
            tokgate[(size_t)row * 4 + k] = gt;
        }
    }
    __syncthreads();
    const int half = (pm * 256) / HALF_T;
    if (F.tid < 32) { const unsigned c = ((LAS unsigned*)(lds + RT_LCNT))[F.tid];
        ((LAS unsigned*)(lds + RT_GBASE))[F.tid] = c ? __hip_atomic_fetch_add(F.ctl + CW_CNT + (half * 32 + F.tid) * 16, c, RLX_AGENT) : 0u; }
    __syncthreads();
    for (int i = F.tid; i < 1024; i += 512) { const int a = ((const LAS int*)(lds + RT_ASG))[i], e = a >> 16, rl = i >> 2, row = pm * 256 + rl;
        const unsigned slot = ((const LAS unsigned*)(lds + RT_GBASE))[e] + (unsigned)(a & 0xffff); const size_t li = (size_t)(half * 32 + e) * LIST_CAP + slot;
        list[li] = row; ((float*)(F.ws + WS_LSCALE))[li] = ((const LAS float*)(lds + RT_HSC))[rl]; tokslot[(size_t)row * 4 + (i & 3)] = (e << 16) | (int)slot; }
#undef RT_ISSUE
}
__device__ __forceinline__ int moe_tables(Frame& F, int half) {
    LAS int* pst = (LAS int*)(F.lds + TAB_PST); LAS int* cnt = (LAS int*)(F.lds + TAB_CNT); LAS int* tile_e = (LAS int*)(F.lds + TAB_TILE);
    __syncthreads();
    if (F.tid < 32) cnt[F.tid] = (int)__hip_atomic_load(F.ctl + CW_CNT + (half * 32 + F.tid) * 16, RLX_AGENT);
    __syncthreads();
    if (F.tid == 0) { int a = 0; for (int e = 0; e < 32; ++e) { pst[e] = a; a += (cnt[e] + 255) >> 8; } pst[32] = a; }
    __syncthreads();
    const int tt = pst[32];
    for (int pm = F.tid; pm < tt; pm += 512) { int e = 0;
#pragma unroll 8
        for (int k = 1; k < 32; ++k) e += (pst[k] <= pm) ? 1 : 0;
        tile_e[pm] = e; }
    __syncthreads();
    return tt;
}
__device__ __forceinline__ void combine_phase(Frame& F, int half) {
    const LAS int* pst = (const LAS int*)(F.lds + TAB_PST);
    const int lane = F.lane, gw = F.bid * NWAVES + F.wave, NGW = F.G * NWAVES;
    f32x4 gv[4], bv[4];
#pragma unroll
    for (int j = 0; j < 4; ++j) { gv[j] = *((const f32x4*)F.in[22] + 2 * lane + (j & 1) + 128 * (j >> 1)); bv[j] = *((const f32x4*)F.in[23] + 2 * lane + (j & 1) + 128 * (j >> 1)); }
    const bf16_t* H = (const bf16_t*)(F.ws + WS_H); const unsigned char* OR = (const unsigned char*)(F.ws + WS_OUTROWS);
    const int* tokslot = (const int*)(F.ws + WS_TOKSLOT); const float* tokgate = (const float*)(F.ws + WS_TOKGATE);
    const int rbeg = half * HALF_T + gw, rend = (half + 1) * HALF_T;
    if (rbeg >= rend) return;
    const int last = rbeg + ((rend - 1 - rbeg) / NGW) * NGW;
    u32x4 tsv = *((const u32x4*)tokslot + rbeg), gtv = *((const u32x4*)tokgate + rbeg);
    u32x2 ow[4][2]; u32x4 hw[2]; float g4[4];
#define CMB_ISSUE(OW, HW, G4, R) do { \
        _Pragma("unroll") for (int k = 0; k < 4; ++k) { const int ts = __builtin_amdgcn_readfirstlane((int)tsv[k]); G4[k] = __uint_as_float((unsigned)__builtin_amdgcn_readfirstlane((int)gtv[k])) * 0.25f; \
            const int e = ts >> 16, slot = ts & 0xffff; const size_t orow = (size_t)pst[e] * 256 + slot; \
            const u32x2* op = (const u32x2*)(OR + orow * DM) + lane; OW[k][0] = op[0]; OW[k][1] = op[64]; } \
        { const u32x4* hp = (const u32x4*)(H + (size_t)(R) * DM) + lane; HW[0] = hp[0]; HW[1] = hp[64]; } } while (0)
#define CMB_ROW(OW, HW, G4, R) do { f32x4 v[4]; \
        _Pragma("unroll") for (int g = 0; g < 2; ++g) { v[2 * g] = (f32x4){bflo(HW[g].x), bfhi(HW[g].x), bflo(HW[g].y), bfhi(HW[g].y)} * ALPHA; v[2 * g + 1] = (f32x4){bflo(HW[g].z), bfhi(HW[g].z), bflo(HW[g].w), bfhi(HW[g].w)} * ALPHA; } \
        _Pragma("unroll") for (int k = 0; k < 4; ++k) _Pragma("unroll") for (int g = 0; g < 2; ++g) { const u32x2 o2 = OW[k][g]; \
                const f32x2 a0 = __builtin_amdgcn_cvt_pk_f32_fp8(o2.x, false), a1 = __builtin_amdgcn_cvt_pk_f32_fp8(o2.x, true), a2 = __builtin_amdgcn_cvt_pk_f32_fp8(o2.y, false), a3 = __builtin_amdgcn_cvt_pk_f32_fp8(o2.y, true); \
                v[2 * g] += (f32x4){a0.x, a0.y, a1.x, a1.y} * G4[k]; v[2 * g + 1] += (f32x4){a2.x, a2.y, a3.x, a3.y} * G4[k]; } \
        float s = 0.f; \
        _Pragma("unroll") for (int j = 0; j < 4; ++j) s += (v[j][0] + v[j][1]) + (v[j][2] + v[j][3]); \
        const float mean = wave_sum(s) * (1.f / DM); float s2 = 0.f; \
        _Pragma("unroll") for (int j = 0; j < 4; ++j) { v[j] = v[j] - mean; s2 += (v[j][0] * v[j][0] + v[j][1] * v[j][1]) + (v[j][2] * v[j][2] + v[j][3] * v[j][3]); } \
        const float rstd = 1.f / sqrtf(wave_sum(s2) * (1.f / DM) + LN_EPS); \
        f32x4* o = (f32x4*)(F.out + (size_t)(R) * DM) + 2 * lane; \
        _Pragma("unroll") for (int j = 0; j < 4; ++j) o[(j & 1) + 128 * (j >> 1)] = v[j] * rstd * gv[j] + bv[j]; } while (0)
    u32x2 owB[4][2]; u32x4 hwB[2]; float g4B[4];
    { const int r1 = rbeg + NGW < last ? rbeg + NGW : last; const u32x4 t2 = *((const u32x4*)tokslot + r1), g2 = *((const u32x4*)tokgate + r1);
      __builtin_amdgcn_sched_barrier(0);
      CMB_ISSUE(ow, hw, g4, rbeg); tsv = t2; gtv = g2; }
    __builtin_amdgcn_sched_barrier(0);
    for (int row = rbeg; row < rend; row += 2 * NGW) {
        const int r1 = row + NGW < last ? row + NGW : last, r2 = row + 2 * NGW < last ? row + 2 * NGW : last, r3 = row + 3 * NGW < last ? row + 3 * NGW : last;
        { const u32x4 t2 = *((const u32x4*)tokslot + r2), g2 = *((const u32x4*)tokgate + r2);
          CMB_ISSUE(owB, hwB, g4B, r1); tsv = t2; gtv = g2; }
        __builtin_amdgcn_sched_barrier(0);
        CMB_ROW(ow, hw, g4, row);
        if (row + NGW >= rend) break;
        { const u32x4 t3 = *((const u32x4*)tokslot + r3), g3 = *((const u32x4*)tokgate + r3);
          CMB_ISSUE(ow, hw, g4, r2); tsv = t3; gtv = g3; }
        __builtin_amdgcn_sched_barrier(0);
        CMB_ROW(owB, hwB, g4B, row + NGW);
    }
}
#undef CMB_ROW
#undef CMB_ISSUE
__device__ __forceinline__ void moe_gateup_phase(Frame& F, int half) {
    const int tt = moe_tables(F, half);
    pg8::MoeOrder S; S.init(tt, 8, F.G, F.bid); S.tile_e = (const LAS int*)(F.lds + TAB_TILE);
    pg8::AGather A{(const char*)(F.ws + WS_HQ), (const int*)(F.ws + WS_LIST) + (size_t)half * 32 * LIST_CAP, (const LAS int*)(F.lds + TAB_PST), (const LAS int*)(F.lds + TAB_CNT)};
    pg8::BPlain B{(const char*)(F.ws + WS_WGU), 1024, (size_t)2048 * 1024};
    pg8::EpiSwiglu E{(unsigned char*)(F.ws + WS_ACT), F.in[19], (const float*)(F.ws + WS_WSGU), (const float*)(F.ws + WS_LSCALE) + (size_t)half * 32 * LIST_CAP, (const LAS int*)(F.lds + TAB_PST), (const LAS int*)(F.lds + TAB_CNT)};
    pg8::gemm_phase<pg8::AGather, pg8::BPlain, pg8::EpiSwiglu, pg8::MoeOrder, true, true, 1>(F.lds, A, B, 8, S, E);
}
__device__ __forceinline__ void moe_down_phase(Frame& F, int half) {
    const int tt = ((const LAS int*)(F.lds + TAB_PST))[32];
    pg8::MoeOrder S; S.init(tt, 4, F.G, F.bid); S.tile_e = (const LAS int*)(F.lds + TAB_TILE);
    pg8::ABlk32 A{(const char*)(F.ws + WS_ACT)};
    pg8::BPlain B{(const char*)(F.ws + WS_WDN), 1024, (size_t)1024 * 1024};
    pg8::EpiDown E{(unsigned char*)(F.ws + WS_OUTROWS), F.in[21], (const float*)(F.ws + WS_WSDN)};
    pg8::gemm_phase<pg8::ABlk32, pg8::BPlain, pg8::EpiDown, pg8::MoeOrder, true, true, 2>(F.lds, A, B, 8, S, E);
}


__device__ __forceinline__ void ph_inproj(Frame& F) {
    unsigned char* ws = F.ws;
    pg8::StaticOrder S; S.init(T / 256, NPROJ / 256, F.G, F.bid);
    pg8::APlain A{(const char*)(ws + WS_XB), 1024u}; pg8::BPlain B{(const char*)(ws + WS_WIN), 1024, 0};
    pg8::EpiProj E{ws, (const float*)(ws + WS_BINP), (const float*)(ws + WS_XS), (const float*)(ws + WS_WSIN)};
    pg8::gemm_phase<pg8::APlain, pg8::BPlain, pg8::EpiProj, pg8::StaticOrder, true, true, 1>(F.lds, A, B, 8, S, E);
}
__device__ __forceinline__ void ph_cmp_attnA(Frame& F) {
    for (int U = F.bid; U < 512; U += F.G) compress_unit(F, U);
    build_bias_tab_ext(F); __syncthreads();
    for (int U = F.bid; U < 2048; U += F.G) attnA_unit(F, U);
}
__device__ __forceinline__ void ph_nsa(Frame& F) {
    const bool early = ((F.bid >> 3) & 1) != 0;
    if (early) { for (int it = F.bid; it < N_EXPERT_ITEMS; it += F.G) expert_quant_item(F, it); }
    build_bias_tab(F); build_bias_tab_extB(F); __syncthreads();
    for (int U = F.bid; U < 2048; U += F.G) nsa_unit(F, U);
    __syncthreads();
    if (!early) { for (int it = F.bid; it < N_EXPERT_ITEMS; it += F.G) expert_quant_item(F, it); }
}
struct PanelOrder { int pm, nun;
    __device__ __forceinline__ bool next(int i, pg8::Unit& u) const { if (i >= nun) return false; int p = pm; asm volatile("" : "+s"(p)); u.pm = p; u.pn = i; u.e = 0; return true; } };
__device__ __forceinline__ void local_sync(Frame& F) {
    if (F.wave == 0) { __builtin_amdgcn_fence(__ATOMIC_ACQUIRE, "agent"); asm volatile("s_waitcnt vmcnt(0)" ::: "memory"); }
    __syncthreads();
}
__device__ __forceinline__ void ph_chain(Frame& F) {
    unsigned char* ws = F.ws;
    const int pm = F.bid;
    if (pm < T / 256) {
        int nun = 4; asm volatile("" : "+s"(nun));
        PanelOrder S{pm, nun};
        { pg8::APlain A{(const char*)(ws + WS_Y), 1024u}; pg8::BPlain B{(const char*)(ws + WS_WAB), 1024, 0};
          pg8::EpiGate<false> E{(unsigned char*)(ws + WS_MERGED), (const unsigned char*)(ws + WS_MG), (const float*)(ws + WS_WSAB)};
          pg8::gemm_phase<pg8::APlain, pg8::BPlain, pg8::EpiGate<false>, PanelOrder, true, true, 2>(F.lds, A, B, 4, S, E); }
        local_sync(F);
        { pg8::APlain A{(const char*)(ws + WS_Y) + 512, 1024u}; pg8::BPlain B{(const char*)(ws + WS_WAB) + 512, 1024, 0};
          pg8::EpiGate<true> E{(unsigned char*)(ws + WS_MERGED), (const unsigned char*)(ws + WS_MG), (const float*)(ws + WS_WSAB) + 1024};
          pg8::gemm_phase<pg8::APlain, pg8::BPlain, pg8::EpiGate<true>, PanelOrder, true, true, 2>(F.lds, A, B, 4, S, E); }
        local_sync(F);
        { pg8::APlain A{(const char*)(ws + WS_MERGED), 1024u}; pg8::BPlain B{(const char*)(ws + WS_WOUT), 1024, 0};
          pg8::EpiMix E{(bf16_t*)F.out, (const float*)(ws + WS_WSAB) + 2048};
          pg8::gemm_phase<pg8::APlain, pg8::BPlain, pg8::EpiMix, PanelOrder, true, true, 2>(F.lds, A, B, 8, S, E); }
        local_sync(F);
        ln1_router_panel(F, pm);
        __syncthreads();
    }
}

constexpr int NPHASE = 8;
struct Args { const float* in[24]; float* out; unsigned char* ws; int ph_lo, ph_hi; };

__global__ void __launch_bounds__(NWAVES * 64, 2) fwd_kernel(Args args) {
    extern __shared__ __attribute__((aligned(16))) unsigned char lds_raw[];
    Frame F;
    F.lds = (LAS unsigned char*)lds_raw;
    F.tid = threadIdx.x; F.lane = F.tid & 63; F.wave = __builtin_amdgcn_readfirstlane(F.tid >> 6);
    F.G = gridDim.x; F.bid = blockIdx.x;
    F.ws = args.ws; F.ctl = (unsigned*)(args.ws + WS_CTL); F.out = args.out;
#pragma unroll
    for (int k = 0; k < 24; ++k) F.in[k] = args.in[k];
    volatile LAS unsigned* MISC = (volatile LAS unsigned*)(F.lds + MISC_OFF);
    if (F.tid < 64) MISC[F.tid] = 0u;
    __syncthreads();
#if MK_ONE_LAUNCH
    XcdBarrier bar = xcd_barrier_post(F.ctl + CW_BAR, MISC + 8);
#define GRID_BAR() xcd_barrier(bar)
#else
#define GRID_BAR() do { } while (0)
#endif
    const int lo = args.ph_lo, hi = args.ph_hi;
#ifndef PHASE_MASK
#define PHASE_MASK 0xffffffffu
#endif
#define IN(k) (((PHASE_MASK >> (k)) & 1u) && lo <= (k) && (k) < hi)
#define SEAM(k) do { if (IN(k) && IN((k) + 1)) GRID_BAR(); } while (0)
#ifndef REPMASK
#define REPMASK 0u
#endif
#define RUN(k, ...) do { if (IN(k)) { __VA_ARGS__; if constexpr (((REPMASK) >> (k)) & 1u) { GRID_BAR(); __VA_ARGS__; } } SEAM(k); } while (0)

    RUN(0, p0_prologue(F));
    RUN(1, ph_inproj(F));
    RUN(2, ph_cmp_attnA(F));
    RUN(3, ph_nsa(F));
    RUN(4, ph_chain(F));
    RUN(5, moe_gateup_phase(F, 0));
    RUN(6, moe_down_phase(F, 0));
    RUN(7, combine_phase(F, 0));
#undef IN
#undef SEAM
}

extern "C" void kernel_launch(void* const* d_in, const int* in_sizes, int n_in, void* d_out, int out_size, void* d_ws, size_t ws_size, hipStream_t stream) {
    static int grid = 0;
    if (grid == 0) {
        if (n_in != 24 || out_size != T * DM || ws_size < WS_END) { fprintf(stderr, "kernel_launch: unexpected sizes (n_in %d out %d ws %zu)\n", n_in, out_size, ws_size); grid = -1; return; }
        int dev = 0, cus = 0, per_cu = 0;
        if (hipGetDevice(&dev) != hipSuccess || hipDeviceGetAttribute(&cus, hipDeviceAttributeMultiprocessorCount, dev) != hipSuccess) { grid = -1; return; }
        if (hipFuncSetAttribute((const void*)fwd_kernel, hipFuncAttributeMaxDynamicSharedMemorySize, LDS_BYTES) != hipSuccess) { fprintf(stderr, "kernel_launch: hipFuncSetAttribute failed\n"); grid = -1; return; }
        if (hipOccupancyMaxActiveBlocksPerMultiprocessor(&per_cu, (const void*)fwd_kernel, NWAVES * 64, LDS_BYTES) != hipSuccess || per_cu < 1) fprintf(stderr, "kernel_launch: occupancy query reports %d\n", per_cu);
        (void)hipGetLastError();
        grid = cus;
    }
    if (grid < 0) return;
    (void)hipMemsetAsync((char*)d_ws + WS_CTL, 0, CTL_ZERO_BYTES, stream);
    Args a{};
    for (int i = 0; i < 24; ++i) a.in[i] = (const float*)d_in[i];
    a.out = (float*)d_out; a.ws = (unsigned char*)d_ws;
#if MK_ONE_LAUNCH
    a.ph_lo = 0; a.ph_hi = NPHASE;
    hipLaunchKernelGGL(fwd_kernel, dim3(grid), dim3(NWAVES * 64), LDS_BYTES, stream, a);
#else
    for (int p = 0; p < NPHASE; ++p) { a.ph_lo = p; a.ph_hi = p + 1; hipLaunchKernelGGL(fwd_kernel, dim3(grid), dim3(NWAVES * 64), LDS_BYTES, stream, a); }
#endif
}
```
